# Optimizing an MI355X kernel written in HIP

```python
import jax, jax.numpy as jnp
from jax import lax
import numpy as np

D_MODEL = 2048
BATCH = 2
SEQ = 8192
DEPTH = 1

NORM_EPS = 1e-6
ROPE_THETA = 10000.0
GLA_HEADS = 4
GLA_DK = 256
GLA_DV = 512
GLA_GATE_RANK = 16
GLA_GATE_NORMALIZER = 16.0
GLA_CHUNK = 64
DSA_HEADS = 16
DSA_KV_HEADS = 4
DSA_HEAD_DIM = 128
IDX_HEADS = 16
IDX_DIM = 128
IDX_ROPE_DIM = 64
TOPK_MAX = 256
Q_BLOCK = 128
D_FF = 4 * D_MODEL
IN_SPLITS = (
    GLA_HEADS * GLA_DK,
    GLA_HEADS * GLA_DK,
    GLA_HEADS * GLA_DV,
    GLA_HEADS * GLA_DV,
    GLA_GATE_RANK,
    DSA_HEADS * DSA_HEAD_DIM,
    DSA_KV_HEADS * DSA_HEAD_DIM,
    DSA_KV_HEADS * DSA_HEAD_DIM,
    IDX_HEADS * IDX_DIM,
    IDX_DIM,
    IDX_HEADS,
    2 * D_MODEL,
)
D_IN_PROJ = sum(IN_SPLITS)

kernel_name = 'hybrid_gla_dsa_block'


def rmsnorm(x, g):
    xf = x.astype(jnp.float32)
    y = xf * lax.rsqrt(jnp.mean(xf * xf, axis=-1, keepdims=True) + NORM_EPS)
    return (y * g.astype(jnp.float32)).astype(x.dtype)


def rope(x, pos, rot_dim):
    half = rot_dim // 2
    inv_freq = ROPE_THETA ** (-jnp.arange(half, dtype=jnp.float32) * 2.0 / rot_dim)
    ang = pos.astype(jnp.float32)[:, None] * inv_freq[None, :]
    cos = jnp.cos(ang)[None, :, None, :]
    sin = jnp.sin(ang)[None, :, None, :]
    xf = x.astype(jnp.float32)
    x1 = xf[..., :half]
    x2 = xf[..., half:rot_dim]
    out = jnp.concatenate([x1 * cos - x2 * sin, x2 * cos + x1 * sin, xf[..., rot_dim:]], axis=-1)
    return out.astype(x.dtype)


def gla_chunked(q, k, v, log_a):
    B, S, H, dk = q.shape
    dv = v.shape[-1]
    C = GLA_CHUNK
    n = S // C

    def chunks(t):
        return t.astype(jnp.float32).reshape(B, n, C, H, t.shape[-1]).transpose(1, 0, 3, 2, 4)

    qc = chunks(q) * (dk ** -0.5)
    kc, vc, gc = chunks(k), chunks(v), chunks(log_a)
    causal = jnp.tril(jnp.ones((C, C), dtype=bool))[:, :, None]

    def step(state, inp):
        qi, ki, vi, gi = inp
        b = jnp.cumsum(gi, axis=2)
        o_inter = jnp.einsum('bhcd,bhde->bhce', qi * jnp.exp(b), state)
        diff = b[:, :, :, None, :] - b[:, :, None, :, :]
        decay = jnp.exp(jnp.where(causal, diff, -jnp.inf))
        scores = jnp.einsum('bhid,bhjd,bhijd->bhij', qi, ki, decay)
        o_intra = jnp.einsum('bhij,bhje->bhie', scores, vi)
        b_last = b[:, :, -1:, :]
        state = state * jnp.exp(b_last[:, :, 0, :])[..., None] + jnp.einsum('bhcd,bhce->bhde', ki * jnp.exp(b_last - b), vi)
        return state, o_inter + o_intra

    state0 = jnp.zeros((B, H, dk, dv), jnp.float32)
    _, out = lax.scan(step, state0, (qc, kc, vc, gc))
    return out.transpose(1, 0, 3, 2, 4).reshape(B, S, H, dv).astype(v.dtype)


def dsa_sparse_attention(q, k, v, q_idx, k_idx, w_idx, topk):
    B, S, H, hd = q.shape
    hkv = k.shape[2]
    grp = H // hkv
    nb = S // Q_BLOCK
    key_pos = jnp.arange(S, dtype=jnp.int32)
    q_pos = key_pos.reshape(nb, Q_BLOCK)
    gather_rows = jax.vmap(lambda t, i: t[i])
    k_idx_f = k_idx.astype(jnp.float32)

    def blocks(t):
        return t.reshape(B, nb, Q_BLOCK, *t.shape[2:]).swapaxes(0, 1)

    def one_block(args):
        qb, qib, wb, qp = args
        rel = jax.nn.relu(jnp.einsum('bthd,bsd->bths', qib.astype(jnp.float32), k_idx_f))
        score = jnp.einsum('bth,bths->bts', wb.astype(jnp.float32), rel)
        score = jnp.where(key_pos[None, None, :] <= qp[None, :, None], score, -jnp.inf)
        _, sel = lax.top_k(score, topk)
        valid = sel <= qp[None, :, None]
        ks = gather_rows(k, sel).astype(jnp.float32)
        vs = gather_rows(v, sel).astype(jnp.float32)
        qg = qb.astype(jnp.float32).reshape(B, Q_BLOCK, hkv, grp, hd)
        logits = jnp.einsum('btkgd,btskd->btkgs', qg, ks) * (hd ** -0.5)
        logits = jnp.where(valid[:, :, None, None, :], logits, -jnp.inf)
        p = jax.nn.softmax(logits, axis=-1)
        o = jnp.einsum('btkgs,btskd->btkgd', p, vs)
        return o.reshape(B, Q_BLOCK, H, hd).astype(v.dtype)

    out = lax.map(one_block, (blocks(q), blocks(q_idx), blocks(w_idx), q_pos))
    return out.swapaxes(0, 1).reshape(B, S, H, hd)


def hybrid_block(x, norm1_g, w_in, gla_wg2, gla_bg, gla_norm_g, w_proj_gla, q_norm_g, k_norm_g,
                 idx_k_norm_g, w_proj_dsa, b_gate, w_out, norm2_g, w_ff1, w_ff2):
    B, S, _ = x.shape
    pos = jnp.arange(S, dtype=jnp.int32)
    topk = min(TOPK_MAX, S // 4)

    h = rmsnorm(x, norm1_g)
    proj = h @ w_in
    points = np.cumsum(IN_SPLITS)[:-1].tolist()
    gq, gk, gv, gr, glr, dq, dk, dv, iq, ik, iw, gates = jnp.split(proj, points, axis=-1)

    log_a = jax.nn.log_sigmoid((glr @ gla_wg2 + gla_bg).astype(jnp.float32)) / GLA_GATE_NORMALIZER
    o_gla = gla_chunked(gq.reshape(B, S, GLA_HEADS, GLA_DK), gk.reshape(B, S, GLA_HEADS, GLA_DK),
                        gv.reshape(B, S, GLA_HEADS, GLA_DV), log_a.reshape(B, S, GLA_HEADS, GLA_DK))
    o_gla = rmsnorm(o_gla, gla_norm_g) * jax.nn.silu(gr.reshape(B, S, GLA_HEADS, GLA_DV))
    y_gla = o_gla.reshape(B, S, GLA_HEADS * GLA_DV) @ w_proj_gla

    dq = rope(rmsnorm(dq.reshape(B, S, DSA_HEADS, DSA_HEAD_DIM), q_norm_g), pos, DSA_HEAD_DIM)
    dk = rope(rmsnorm(dk.reshape(B, S, DSA_KV_HEADS, DSA_HEAD_DIM), k_norm_g), pos, DSA_HEAD_DIM)
    dv = dv.reshape(B, S, DSA_KV_HEADS, DSA_HEAD_DIM)
    iq = rope(iq.reshape(B, S, IDX_HEADS, IDX_DIM), pos, IDX_ROPE_DIM) * (IDX_DIM ** -0.5)
    ik = rope(rmsnorm(ik, idx_k_norm_g)[:, :, None, :], pos, IDX_ROPE_DIM)[:, :, 0, :]
    iw = iw * (IDX_HEADS ** -0.5)
    o_dsa = dsa_sparse_attention(dq, dk, dv, iq, ik, iw, topk)
    y_dsa = o_dsa.reshape(B, S, DSA_HEADS * DSA_HEAD_DIM) @ w_proj_dsa

    g_gla, g_dsa = jnp.split(jax.nn.sigmoid(gates + b_gate), 2, axis=-1)
    x = x + (g_gla * y_gla + g_dsa * y_dsa) @ w_out

    h2 = rmsnorm(x, norm2_g)
    return x + jnp.square(jax.nn.relu(h2 @ w_ff1)) @ w_ff2


def setup_inputs(seed: int = 0) -> dict:
    key = jax.random.key(seed)
    ks = jax.random.split(key, 16)

    def nrm(k, shape, scale):
        return jax.random.normal(k, shape, jnp.float32) * scale

    def gain(k, n):
        return 1.0 + nrm(k, (DEPTH, n), 0.02)

    return {
        'x': nrm(ks[0], (BATCH, SEQ, D_MODEL), 1.0),
        'norm1_g': gain(ks[1], D_MODEL),
        'w_in': nrm(ks[2], (DEPTH, D_MODEL, D_IN_PROJ), D_MODEL ** -0.5),
        'gla_wg2': nrm(ks[3], (DEPTH, GLA_GATE_RANK, GLA_HEADS * GLA_DK), GLA_GATE_RANK ** -0.5),
        'gla_bg': nrm(ks[4], (DEPTH, GLA_HEADS * GLA_DK), 0.1),
        'gla_norm_g': gain(ks[5], GLA_DV),
        'w_proj_gla': nrm(ks[6], (DEPTH, GLA_HEADS * GLA_DV, D_MODEL), (GLA_HEADS * GLA_DV) ** -0.5),
        'q_norm_g': gain(ks[7], DSA_HEAD_DIM),
        'k_norm_g': gain(ks[8], DSA_HEAD_DIM),
        'idx_k_norm_g': gain(ks[9], IDX_DIM),
        'w_proj_dsa': nrm(ks[10], (DEPTH, DSA_HEADS * DSA_HEAD_DIM, D_MODEL), (DSA_HEADS * DSA_HEAD_DIM) ** -0.5),
        'b_gate': nrm(ks[11], (DEPTH, 2 * D_MODEL), 0.02),
        'w_out': nrm(ks[12], (DEPTH, D_MODEL, D_MODEL), D_MODEL ** -0.5),
        'norm2_g': gain(ks[13], D_MODEL),
        'w_ff1': nrm(ks[14], (DEPTH, D_MODEL, D_FF), D_MODEL ** -0.5),
        'w_ff2': nrm(ks[15], (DEPTH, D_FF, D_MODEL), D_FF ** -0.5),
    }


def reference(x, norm1_g, w_in, gla_wg2, gla_bg, gla_norm_g, w_proj_gla, q_norm_g, k_norm_g,
              idx_k_norm_g, w_proj_dsa, b_gate, w_out, norm2_g, w_ff1, w_ff2):
    for l in range(DEPTH):
        x = hybrid_block(x, norm1_g[l], w_in[l], gla_wg2[l], gla_bg[l], gla_norm_g[l], w_proj_gla[l],
                         q_norm_g[l], k_norm_g[l], idx_k_norm_g[l], w_proj_dsa[l], b_gate[l], w_out[l],
                         norm2_g[l], w_ff1[l], w_ff2[l])
    return x
```

```cpp
#include <hip/hip_runtime.h>
#include <hip/hip_cooperative_groups.h>
#include <cstdio>
#include <cstdint>
namespace cg = cooperative_groups;

#define LAS __attribute__((address_space(3)))
typedef unsigned short bf16_t;
typedef short bf16x8 __attribute__((ext_vector_type(8)));
typedef float f32x4 __attribute__((ext_vector_type(4)));
typedef unsigned u32x4 __attribute__((ext_vector_type(4)));
typedef unsigned u32x2 __attribute__((ext_vector_type(2)));

constexpr int T = 16384, SEQ = 8192, DM = 2048, DFF = 8192, NPROJ = 15520, NPROJ_PAD = 15616;
constexpr float EPS = 1e-6f;
constexpr size_t MiB = 1u << 20;
constexpr size_t WS_GLR = 1 * MiB, WS_IW = 2 * MiB, WS_BLAST = 3 * MiB, WS_ROPE1 = 4 * MiB, WS_ROPE2 = 8 * MiB, WS_IK = 10 * MiB, WS_IDX = 14 * MiB, WS_CNT = 22 * MiB;
constexpr size_t WS_GQ = 24 * MiB, WS_GK = 56 * MiB, WS_VT = 88 * MiB, WS_GR = 152 * MiB, WS_DQ = 216 * MiB, WS_DK = 280 * MiB, WS_DV = 296 * MiB, WS_IQ = 312 * MiB;
constexpr size_t WS_WTIN = 376 * MiB, WS_H = 437 * MiB;
constexpr size_t WS_SC = 376 * MiB;
constexpr size_t WS_QS = 280 * MiB, WS_P = 312 * MiB, WS_ST = 344 * MiB, WS_KT = 408 * MiB, WS_OG = 440 * MiB;
constexpr size_t WS_WPG = 24 * MiB, WS_WPD = 32 * MiB, WS_WO = 40 * MiB, WS_WF1 = 48 * MiB, WS_WF2 = 80 * MiB;
constexpr size_t WS_U = 280 * MiB, WS_H2 = 440 * MiB, WS_HM = 112 * MiB;
constexpr size_t WS_RSS = 22 * MiB;
constexpr size_t WS_NEED = 512 * MiB;

__device__ __forceinline__ unsigned cvt_pk_bf16(float lo, float hi) { unsigned r; asm volatile("v_cvt_pk_bf16_f32 %0, %1, %2" : "=v"(r) : "v"(lo), "v"(hi)); return r; }
__device__ __forceinline__ float bf2f(unsigned short b) { return __uint_as_float(((unsigned)b) << 16); }
__device__ __forceinline__ float bflo(unsigned w) { return __uint_as_float(w << 16); }
__device__ __forceinline__ float bfhi(unsigned w) { return __uint_as_float(w & 0xffff0000u); }
__device__ __forceinline__ unsigned short f2bf(float f) { return (unsigned short)(cvt_pk_bf16(f, 0.f) & 0xffffu); }
__device__ __forceinline__ float shx(float v, int m, int lane) { return __int_as_float(__builtin_amdgcn_ds_bpermute((lane ^ m) << 2, __float_as_int(v))); }
#define DPPF(v, ctrl) __int_as_float(__builtin_amdgcn_update_dpp(0, __float_as_int(v), (ctrl), 0xf, 0xf, false))
__device__ __forceinline__ float row16_sum(float x) { x += DPPF(x, 0xB1); x += DPPF(x, 0x4E); x += DPPF(x, 0x141); x += DPPF(x, 0x140); return x; }
__device__ __forceinline__ float wave_sum(float v, int lane) {
    (void)lane; const float x = row16_sum(v);
    return (__int_as_float(__builtin_amdgcn_readlane(__float_as_int(x), 0)) + __int_as_float(__builtin_amdgcn_readlane(__float_as_int(x), 16)))
         + (__int_as_float(__builtin_amdgcn_readlane(__float_as_int(x), 32)) + __int_as_float(__builtin_amdgcn_readlane(__float_as_int(x), 48)));
}
__device__ __forceinline__ u32x4 pack8(f32x4 a, f32x4 b) { u32x4 w; w.x = cvt_pk_bf16(a[0], a[1]); w.y = cvt_pk_bf16(a[2], a[3]); w.z = cvt_pk_bf16(b[0], b[1]); w.w = cvt_pk_bf16(b[2], b[3]); return w; }

namespace pg8 {
constexpr int BM = 256, BK = 64, HALF = 128, HTB = HALF * BK * 2, STAGE_BYTES = 8 * HTB, NXCD = 8, WGM = 8;
__host__ __device__ __forceinline__ int lds_byte(int r, int c) { const int st = (r >> 4) * 2 + (c >> 5), rr = r & 15, cc = c & 31, ob = rr * 64 + cc * 2; return st * 1024 + (ob ^ (((ob >> 9) & 1) << 5)); }
__host__ __device__ __forceinline__ void stage_rc(int b, int& R, int& C) { const int st = b / 1024, sb = b % 1024, swz = sb ^ (((sb >> 9) & 1) << 5); R = (st >> 1) * 16 + swz / 64; C = (st & 1) * 32 + (swz % 64) / 2; }
__host__ __device__ __forceinline__ int perm32(int rho) { const int n = rho >> 4, i = rho & 15; return 8 * (i >> 2) + 4 * n + (i & 3); }

__device__ __forceinline__ void glds16s(const void* sbase, unsigned voff, unsigned lds_dst) { unsigned keep;
    asm volatile("s_mov_b32 %0, m0\n\ts_mov_b32 m0, %3\n\ts_nop 0\n\tglobal_load_lds_dwordx4 %1, %2\n\ts_mov_b32 m0, %0" : "=&s"(keep) : "v"(voff), "s"(sbase), "s"(lds_dst) : "memory"); }
struct Unit { int pm, pn; long offA, offB; int chain, aux; };
struct Gemm { const bf16_t* A; const bf16_t* Bt; int lda, ldb, K; };

struct StaticOrder {
    int nM, nN, nwg, G, c; long sA, sB;
    __device__ void init(int M, int N, int lda, int ldb, int G_, int c_) { nM = M / BM; nN = N / BM; nwg = nM * nN; G = G_; c = c_; sA = (long)BM * lda * 2; sB = (long)BM * ldb * 2; }
    __device__ bool next(int i, Unit& u) const {
        const long L = (long)i * G + c; if (L >= nwg) return false;
        int wgid = (int)L; { const int q = nwg / NXCD, r = nwg % NXCD, xcd = wgid % NXCD, off = wgid / NXCD; wgid = (xcd < r ? xcd * (q + 1) : r * (q + 1) + (xcd - r) * q) + off; }
        const int nig = WGM * nN, gid = wgid / nig, fm = gid * WGM, gsz = (nM - fm) < WGM ? (nM - fm) : WGM;
        u.pm = fm + ((wgid % nig) % gsz); u.pn = (wgid % nig) / gsz; u.offA = u.pm * sA; u.offB = u.pn * sB; u.chain = 0; u.aux = 0; return true;
    }
};

template <class Epi, class Sched, bool ALIGN_EPI>
__device__ __forceinline__ void gemm_phase(LAS unsigned char* lds, const Gemm g, const Sched& S, const Epi& E, int wid) {
    int lane; asm volatile("v_mbcnt_lo_u32_b32 %0, -1, 0\n\tv_mbcnt_hi_u32_b32 %0, -1, %0" : "=v"(lane));
    const int tid = wid * 64 + lane; const int wr = wid >> 2, wc = wid & 3, fr = lane & 15, fq = lane >> 4;
    const int K = g.K, nt = K / BK;
    unsigned voffA[2], voffB[2];
#pragma unroll
    for (int i = 0; i < 2; ++i) { int R, C; stage_rc(tid * 16 + i * 8192, R, C); const int Rb = (R & ~31) + perm32(R & 31);
        voffA[i] = (unsigned)(R * g.lda + C) * 2u; voffB[i] = (unsigned)(Rb * g.ldb + C) * 2u; }
    const size_t kstep = (size_t)(BK * 2);
    const size_t hstepA = (size_t)HALF * g.lda * 2, hstepB = (size_t)HALF * g.ldb * 2;
    const unsigned ldsw = (unsigned)wid * 1024u;
    const int aoff = lds_byte(wr * 64 + fr, fq * 8), boff = lds_byte(wc * 32 + fr, fq * 8);
#define PG8_SA(b, h) (((b) * 2 + (h)) * HTB)
#define PG8_SB(b, h) ((4 + (b) * 2 + (h)) * HTB)
#define PG8_STAGE(bufoff, gbase, voff) do { _Pragma("unroll") for (int _i = 0; _i < 2; ++_i) \
        glds16s((const void*)(gbase), (voff)[_i], (unsigned)(size_t)(lds + (bufoff) + ldsw + _i * 8192)); } while (0)
#define PG8_LDA(dst, b, h) do { _Pragma("unroll") for (int m = 0; m < 4; ++m) _Pragma("unroll") for (int k = 0; k < 2; ++k) dst[m][k] = *(const LAS bf16x8*)(lds + PG8_SA(b, h) + aoff + m * 2048 + k * 1024); } while (0)
#define PG8_LDB(dst, b, h) do { _Pragma("unroll") for (int n = 0; n < 2; ++n) _Pragma("unroll") for (int k = 0; k < 2; ++k) dst[n][k] = *(const LAS bf16x8*)(lds + PG8_SB(b, h) + boff + n * 2048 + k * 1024); } while (0)
#define PG8_MMA(ai, bj, At, Bt) do { __builtin_amdgcn_s_setprio(1); _Pragma("unroll") for (int m = 0; m < 4; ++m) _Pragma("unroll") for (int n = 0; n < 2; ++n) _Pragma("unroll") for (int k = 0; k < 2; ++k) \
        acc[ai][bj][m][n] = __builtin_amdgcn_mfma_f32_16x16x32_bf16(Bt[n][k], At[m][k], acc[ai][bj][m][n], 0, 0, 0); __builtin_amdgcn_s_setprio(0); } while (0)
#define PG8_WAIT_V(n) asm volatile("s_waitcnt vmcnt(" #n ")" ::: "memory")
#define PG8_WAIT_L(n) asm volatile("s_waitcnt lgkmcnt(" #n ")" ::: "memory")
#define PG8_BAR __builtin_amdgcn_s_barrier()
#define PG8_SCHED __builtin_amdgcn_sched_barrier(0)
    Unit cur, nxt; int ui = 0;
    if (!S.next(0, cur)) return;
    f32x4 acc[2][2][4][2];
#pragma unroll
    for (int a = 0; a < 2; ++a)
#pragma unroll
        for (int b = 0; b < 2; ++b)
#pragma unroll
            for (int m = 0; m < 4; ++m)
#pragma unroll
                for (int n = 0; n < 2; ++n) acc[a][b][m][n] = (f32x4){0.f, 0.f, 0.f, 0.f};
    bf16x8 At[4][2], B0[2][2], B1[2][2];
    const char* cA = (const char*)g.A + cur.offA; const char* cB = (const char*)g.Bt + cur.offB;
    PG8_STAGE(PG8_SB(0, 0), cB, voffB); PG8_STAGE(PG8_SB(0, 1), cB + hstepB, voffB); PG8_STAGE(PG8_SA(0, 0), cA, voffA); PG8_STAGE(PG8_SA(0, 1), cA + hstepA, voffA);
    if (wr == 1) PG8_BAR;
    PG8_WAIT_V(2); PG8_BAR;
    PG8_STAGE(PG8_SB(1, 0), cB + kstep, voffB); PG8_STAGE(PG8_SA(1, 0), cA + kstep, voffA); PG8_STAGE(PG8_SB(1, 1), cB + hstepB + kstep, voffB);
    PG8_WAIT_V(6); PG8_BAR;
    for (;;) {
        const bool has_next = S.next(ui + 1, nxt);
        const char* nA = has_next ? (const char*)g.A + nxt.offA : cA; const char* nB = has_next ? (const char*)g.Bt + nxt.offB : cB;
        for (int t = 0; t < nt; t += 2) {
            const bool last = (t == nt - 2);
            const char* a1 = cA + (size_t)(t + 1) * kstep;
            const char* a2 = last ? nA : cA + (size_t)(t + 2) * kstep; const char* b2 = last ? nB : cB + (size_t)(t + 2) * kstep;
            const char* a3 = a2 + kstep; const char* b3 = b2 + kstep;
            PG8_LDB(B0, 0, 0); PG8_LDB(B1, 0, 1); PG8_SCHED; PG8_LDA(At, 0, 0); PG8_STAGE(PG8_SA(1, 1), a1 + hstepA, voffA);
            PG8_WAIT_V(8); PG8_WAIT_L(0); PG8_BAR; PG8_MMA(0, 0, At, B0); PG8_MMA(0, 1, At, B1); PG8_BAR; PG8_SCHED;
            PG8_LDA(At, 0, 1); PG8_STAGE(PG8_SB(0, 0), b2, voffB); PG8_STAGE(PG8_SB(0, 1), b2 + hstepB, voffB); PG8_STAGE(PG8_SA(0, 0), a2, voffA);
            PG8_WAIT_V(8); PG8_WAIT_L(0); PG8_BAR; PG8_MMA(1, 0, At, B0); PG8_MMA(1, 1, At, B1); PG8_BAR; PG8_SCHED;
            PG8_LDB(B0, 1, 0); PG8_LDB(B1, 1, 1); PG8_SCHED; PG8_LDA(At, 1, 0); PG8_STAGE(PG8_SA(0, 1), a2 + hstepA, voffA);
            PG8_WAIT_V(8); PG8_WAIT_L(0); PG8_BAR; PG8_MMA(0, 0, At, B0); PG8_MMA(0, 1, At, B1); PG8_BAR; PG8_SCHED;
            PG8_LDA(At, 1, 1); PG8_STAGE(PG8_SB(1, 0), b3, voffB); PG8_STAGE(PG8_SB(1, 1), b3 + hstepB, voffB); PG8_STAGE(PG8_SA(1, 0), a3, voffA);
            PG8_WAIT_V(8); PG8_WAIT_L(0); PG8_BAR; PG8_MMA(1, 0, At, B0); PG8_MMA(1, 1, At, B1); PG8_BAR; PG8_SCHED;
        }
        if (!cur.chain) {
            if constexpr (ALIGN_EPI) { if (wr == 0) PG8_BAR; }
            E(acc, cur, wr, wc, fr, fq);
        }
        if (!has_next) break;
        if (!cur.chain) {
#pragma unroll
            for (int a = 0; a < 2; ++a)
#pragma unroll
                for (int b = 0; b < 2; ++b)
#pragma unroll
                    for (int m = 0; m < 4; ++m)
#pragma unroll
                        for (int n = 0; n < 2; ++n) acc[a][b][m][n] = (f32x4){0.f, 0.f, 0.f, 0.f};
            if constexpr (ALIGN_EPI) { if (wr == 1) PG8_BAR; }
        }
        cur = nxt; cA = nA; cB = nB; ++ui;
    }
    PG8_WAIT_V(0);
    if constexpr (!ALIGN_EPI) { if (wr == 0) PG8_BAR; }
    PG8_BAR;
#undef PG8_SA
#undef PG8_SB
#undef PG8_STAGE
#undef PG8_LDA
#undef PG8_LDB
#undef PG8_MMA
#undef PG8_WAIT_V
#undef PG8_WAIT_L
#undef PG8_BAR
#undef PG8_SCHED
}
}
using pg8::Unit; using pg8::Gemm;

struct Args {
    const float *x, *norm1_g, *w_in, *gla_wg2, *gla_bg, *gla_norm_g, *w_proj_gla, *q_norm_g, *k_norm_g, *idx_k_norm_g, *w_proj_dsa, *b_gate, *w_out, *norm2_g, *w_ff1, *w_ff2;
    float* out; unsigned char* ws; int ph_lo, ph_hi;
};

enum { M_INPROJ = 0, M_INDEX, M_G0, M_G1, M_G2, M_MERGE, M_OUT, M_FF1, M_FF2 };
__device__ __forceinline__ void st8bf(bf16_t* p, f32x4 a, f32x4 b) { *(u32x4*)p = pack8(a, b); }
__device__ __forceinline__ float sigm(float v) { return 1.f / (1.f + __expf(-v)); }

template <int MODE> struct Epi {
    static constexpr bool PERM = true;
    const Args* ap; int batch;
    __device__ __forceinline__ void operator()(const f32x4 (&acc)[2][2][4][2], const Unit& u, int wr, int wc, int fr, int fq) const {
        asm volatile("" : "+v"(fr), "+v"(fq));
        const Args& A = *ap; unsigned char* ws = A.ws;
        if constexpr (MODE == M_INDEX) {
            const float* IW = (const float*)(ws + WS_IW);
            f32x4 w[2][2];
#pragma unroll
            for (int bj = 0; bj < 2; ++bj) { const int t = u.pn * 16 + bj * 8 + wc * 2 + (fq >> 1); const float* wp = IW + (size_t)(batch * SEQ + t) * 16 + (fq & 1) * 8;
                w[bj][0] = *(const f32x4*)wp; w[bj][1] = *(const f32x4*)(wp + 4); }
            _Float16* SC = (_Float16*)(ws + WS_SC);
#pragma unroll
            for (int ai = 0; ai < 2; ++ai)
#pragma unroll
                for (int m = 0; m < 4; ++m) { const int s = u.pm * 256 + ai * 128 + wr * 64 + m * 16 + fr;
#pragma unroll
                    for (int bj = 0; bj < 2; ++bj) { const int t = u.pn * 16 + bj * 8 + wc * 2 + (fq >> 1);
                        const f32x4 v0 = acc[ai][bj][m][0], v1 = acc[ai][bj][m][1]; float sc = 0.f;
#pragma unroll
                        for (int q = 0; q < 4; ++q) { sc += w[bj][0][q] * fmaxf(v0[q], 0.f); sc += w[bj][1][q] * fmaxf(v1[q], 0.f); }
                        sc += shx(sc, 16, fq * 16 + fr);
                        if (!(fq & 1)) SC[(size_t)t * SEQ + s] = (_Float16)sc; } }
        } else {
            f32x4 cb[2][2];
            if constexpr (MODE == M_INPROJ) { if (u.pn >= 44 && u.pn < 60) {
#pragma unroll
                for (int bj = 0; bj < 2; ++bj) { const float* bp = A.b_gate + (u.pn - 44) * 256 + bj * 128 + wc * 32 + fq * 8; cb[bj][0] = *(const f32x4*)bp; cb[bj][1] = *(const f32x4*)(bp + 4); } } }
            if constexpr (MODE == M_G0) {
#pragma unroll
                for (int bj = 0; bj < 2; ++bj) { const float* bl = (const float*)(ws + WS_BLAST) + u.aux * 256 + bj * 128 + wc * 32 + fq * 8; const f32x4 e0 = *(const f32x4*)bl, e1 = *(const f32x4*)(bl + 4);
#pragma unroll
                    for (int q = 0; q < 4; ++q) { cb[bj][0][q] = __expf(e0[q]); cb[bj][1][q] = __expf(e1[q]); } } }
#pragma unroll
            for (int ai = 0; ai < 2; ++ai) {
                u32x4 pg[4][2], pu[4][2]; f32x4 px[4][2][2];
                float rstd[4]; (void)rstd;
                if constexpr (MODE == M_FF1) {
#pragma unroll
                    for (int m = 0; m < 4; ++m) rstd[m] = rsqrtf(((const float*)(ws + WS_RSS))[u.pm * 256 + ai * 128 + wr * 64 + m * 16 + fr] * (1.f / 2048.f) + EPS);
                }
                if constexpr (MODE == M_MERGE || MODE == M_OUT || MODE == M_FF2) {
#pragma unroll
                    for (int m = 0; m < 4; ++m)
#pragma unroll
                        for (int bj = 0; bj < 2; ++bj) { const int r = u.pm * 256 + ai * 128 + wr * 64 + m * 16 + fr, col = u.pn * 256 + bj * 128 + wc * 32 + fq * 8;
                            if constexpr (MODE == M_MERGE) { pg[m][bj] = *(const u32x4*)((const bf16_t*)A.out + (size_t)r * 4096 + u.aux * 2048 + col);
                                if (u.aux) pu[m][bj] = *(const u32x4*)((const bf16_t*)(ws + WS_U) + (size_t)r * 2048 + col); }
                            else { const float* xp = (MODE == M_OUT ? A.x : A.out) + (size_t)r * 2048 + col; px[m][bj][0] = *(const f32x4*)xp; px[m][bj][1] = *(const f32x4*)(xp + 4); } }
                }
#pragma unroll
                for (int m = 0; m < 4; ++m) {
                    const int rl = ai * 128 + wr * 64 + m * 16 + fr; const int r = u.pm * 256 + rl;
                    float rowss = 0.f; (void)rowss;
#pragma unroll
                    for (int bj = 0; bj < 2; ++bj) {
                        const int cl = bj * 128 + wc * 32 + fq * 8;
                        f32x4 v0 = acc[ai][bj][m][0], v1 = acc[ai][bj][m][1];
                        if constexpr (MODE == M_INPROJ) {
                            const int pn = u.pn;
                            if (pn < 4) { st8bf((bf16_t*)(ws + WS_GQ) + (size_t)r * 1024 + pn * 256 + cl, v0 * 0.0625f, v1 * 0.0625f); }
                            else if (pn < 8) { st8bf((bf16_t*)(ws + WS_GK) + (size_t)r * 1024 + (pn - 4) * 256 + cl, v0, v1); }
                            else if (pn < 16) {
                                const int col = (pn - 8) * 256 + cl, h = col >> 9, e = col & 511, b = r >> 13, s = r & 8191, c = s >> 8, j = s & 255;
                                bf16_t* p = (bf16_t*)(ws + WS_VT) + ((size_t)(((b * 4 + h) * 32 + c) * 512 + e)) * 256 + j;
#pragma unroll
                                for (int q = 0; q < 4; ++q) { p[q * 256] = f2bf(v0[q]); p[(q + 4) * 256] = f2bf(v1[q]); }
                            }
                            else if (pn < 24) {
#pragma unroll
                                for (int q = 0; q < 4; ++q) { v0[q] = v0[q] * sigm(v0[q]); v1[q] = v1[q] * sigm(v1[q]); }
                                st8bf((bf16_t*)(ws + WS_GR) + (size_t)r * 2048 + (pn - 16) * 256 + cl, v0, v1); }
                            else if (pn < 32) { st8bf((bf16_t*)(ws + WS_DQ) + (size_t)r * 2048 + (pn - 24) * 256 + cl, v0, v1); }
                            else if (pn < 36) {
                                const int col = ((pn - 32) & 1) * 256 + cl, kvh = col >> 7, d = col & 127, b = r >> 13, s = r & 8191;
                                bf16_t* base = (bf16_t*)(ws + (pn < 34 ? WS_DK : WS_DV));
                                st8bf(base + ((size_t)((b * 4 + kvh) * 8192 + s)) * 128 + d, v0, v1); }
                            else if (pn < 44) { st8bf((bf16_t*)(ws + WS_IQ) + (size_t)r * 2048 + (pn - 36) * 256 + cl, v0, v1); }
                            else if (pn < 60) {
                                const int col = (pn - 44) * 256 + cl;
#pragma unroll
                                for (int q = 0; q < 4; ++q) { v0[q] = sigm(v0[q] + cb[bj][0][q]); v1[q] = sigm(v1[q] + cb[bj][1][q]); }
                                st8bf((bf16_t*)A.out + (size_t)r * 4096 + col, v0, v1); }
                            else {
                                if (cl < 16) { float* p = (float*)(ws + WS_GLR) + (size_t)r * 16 + cl; *(f32x4*)p = v0; *(f32x4*)(p + 4) = v1; }
                                else if (cl < 32) { float* p = (float*)(ws + WS_IW) + (size_t)r * 16 + (cl - 16); *(f32x4*)p = v0 * 0.25f; *(f32x4*)(p + 4) = v1 * 0.25f; }
                                else if (cl < 160) { st8bf((bf16_t*)(ws + WS_IK) + (size_t)r * 128 + (cl - 32), v0, v1); }
                            }
                        } else if constexpr (MODE == M_G0) {
                            v0 = v0 * cb[bj][0]; v1 = v1 * cb[bj][1];
                            st8bf((bf16_t*)(ws + WS_ST) + ((size_t)u.aux * 512 + u.pm * 256 + rl) * 256 + cl, v0, v1);
                        } else if constexpr (MODE == M_G1) {
#pragma unroll
                            for (int q = 0; q < 4; ++q) { if (cl + q > rl) v0[q] = 0.f; if (cl + 4 + q > rl) v1[q] = 0.f; }
                            st8bf((bf16_t*)(ws + WS_P) + ((size_t)u.aux * 256 + rl) * 256 + cl, v0, v1);
                        } else if constexpr (MODE == M_G2) {
                            const int uu = u.aux, c = uu & 31, h = (uu >> 5) & 3, b = uu >> 7;
                            st8bf((bf16_t*)(ws + WS_OG) + ((size_t)(b * 8192 + c * 256 + rl)) * 2048 + h * 512 + u.pn * 256 + cl, v0, v1);
                        } else if constexpr (MODE == M_MERGE) {
                            const int col = u.pn * 256 + cl;
                            const u32x4 gw = pg[m][bj];
                            bf16_t* up = (bf16_t*)(ws + WS_U) + (size_t)r * 2048 + col;
                            f32x4 g0 = {bflo(gw.x), bfhi(gw.x), bflo(gw.y), bfhi(gw.y)}, g1 = {bflo(gw.z), bfhi(gw.z), bflo(gw.w), bfhi(gw.w)};
                            v0 = v0 * g0; v1 = v1 * g1;
                            if (u.aux) { const u32x4 pw = pu[m][bj]; v0 += (f32x4){bflo(pw.x), bfhi(pw.x), bflo(pw.y), bfhi(pw.y)}; v1 += (f32x4){bflo(pw.z), bfhi(pw.z), bflo(pw.w), bfhi(pw.w)}; }
                            st8bf(up, v0, v1);
                        } else if constexpr (MODE == M_OUT) {
                            const size_t o = (size_t)r * 2048 + u.pn * 256 + cl;
                            const f32x4 y0 = px[m][bj][0] + v0, y1 = px[m][bj][1] + v1;
                            *(f32x4*)(A.out + o) = y0; *(f32x4*)(A.out + o + 4) = y1;
                            st8bf((bf16_t*)(ws + WS_H2) + o, y0, y1);
#pragma unroll
                            for (int q = 0; q < 4; ++q) rowss += y0[q] * y0[q] + y1[q] * y1[q];
                        } else if constexpr (MODE == M_FF1) {
#pragma unroll
                            for (int q = 0; q < 4; ++q) { const float a = fmaxf(v0[q], 0.f) * rstd[m], b = fmaxf(v1[q], 0.f) * rstd[m]; v0[q] = a * a; v1[q] = b * b; }
                            st8bf((bf16_t*)(ws + WS_HM) + (size_t)r * 8192 + u.pn * 256 + cl, v0, v1);
                        } else if constexpr (MODE == M_FF2) {
                            float* o = A.out + (size_t)r * 2048 + u.pn * 256 + cl;
                            *(f32x4*)o = px[m][bj][0] + v0; *(f32x4*)(o + 4) = px[m][bj][1] + v1;
                        }
                    }
                    if constexpr (MODE == M_OUT) {
                        const int ln = fq * 16 + fr;
                        rowss += shx(rowss, 16, ln); rowss += shx(rowss, 32, ln);
                        if (fq == 0) __hip_atomic_fetch_add((float*)(ws + WS_RSS) + r, rowss, __ATOMIC_RELAXED, __HIP_MEMORY_SCOPE_AGENT);
                    }
                }
            }
        }
    }
};

struct IndexOrder {
    int G, c;
    __device__ bool next(int i, Unit& u) const {
        const int L = i * G + c; if (L >= 8448) return false;
        int qb = 0; while (16 * (qb + 1) * (qb + 2) / 2 <= L) ++qb;
        const int rem = L - 16 * qb * (qb + 1) / 2; u.pm = rem >> 4; u.pn = qb * 16 + (rem & 15);
        u.offA = (long)u.pm * 256 * 128 * 2; u.offB = (long)u.pn * 256 * 128 * 2; u.chain = 0; u.aux = 0; return true;
    }
};
struct G0Order {
    int G, c;
    __device__ bool next(int i, Unit& u) const {
        const int L = i * G + c; if (L >= 512) return false;
        const int uu = L >> 1, et = L & 1; u.pm = et; u.pn = 0; u.aux = uu;
        u.offA = (long)(WS_VT) + ((long)uu * 512 + et * 256) * 256 * 2; u.offB = (long)(WS_KT) + (long)uu * 256 * 256 * 2; u.chain = 0; return true;
    }
};
struct G1Order {
    int G, c;
    __device__ bool next(int i, Unit& u) const {
        const int L = i * G + c; if (L >= 256) return false;
        const int c_ = L & 31, h = (L >> 5) & 3, b = L >> 7; u.pm = 0; u.pn = 0; u.aux = L;
        const long off = ((long)(b * 8192 + c_ * 256) * 1024 + h * 256) * 2;
        u.offA = (long)WS_QS + (long)L * 256 * 256 * 2; u.offB = (long)WS_GK + off; u.chain = 0; return true;
    }
};
struct G2Order {
    int G, c;
    __device__ bool next(int i, Unit& u) const {
        const int L = (i >> 1) * G + c; if (L >= 512) return false;
        const int uu = L >> 1, nt_ = L & 1, part = i & 1; u.pm = 0; u.pn = nt_; u.aux = uu;
        if (part == 0) { u.offA = (long)WS_QS + (long)uu * 256 * 256 * 2; u.offB = (long)WS_ST + ((long)uu * 512 + nt_ * 256) * 256 * 2; u.chain = 1; }
        else           { u.offA = (long)WS_P  + (long)uu * 256 * 256 * 2; u.offB = (long)WS_VT + ((long)uu * 512 + nt_ * 256) * 256 * 2; u.chain = 0; }
        return true;
    }
};
struct MergeOrder {
    pg8::StaticOrder so;
    __device__ bool next(int i, Unit& u) const {
        if (!so.next(i >> 1, u)) return false;
        const int which = i & 1; u.aux = which;
        u.offA = (long)(which ? WS_DQ : WS_OG) + (long)u.pm * 256 * 2048 * 2; u.offB = (long)(which ? WS_WPD : WS_WPG) + (long)u.pn * 256 * 2048 * 2; return true;
    }
};

__device__ __forceinline__ int in_dst_row(int n) {
    if (n < 6144) return n;
    if (n < 6160) return 15360 + (n - 6144);
    if (n < 8208) return 6144 + (n - 6160);
    if (n < 8720) return 8192 + (n - 8208);
    if (n < 9232) return 8704 + (n - 8720);
    if (n < 11280) return 9216 + (n - 9232);
    if (n < 11408) return 15360 + 32 + (n - 11280);
    if (n < 11424) return 15360 + 16 + (n - 11408);
    return 11264 + (n - 11424);
}
template <bool MAP> __device__ __forceinline__ void transpose_item(const float* W, int K, int N, bf16_t* WT, LAS float* scr, int item, int lane, const float* rs = nullptr) {
    const int nblk = N / 32, kb = item / nblk, nb = item % nblk, k0 = 64 * kb, n0 = 32 * nb;
    float tv[32];
#pragma unroll
    for (int i = 0; i < 32; ++i) { const int kk = 2 * i + (lane >> 5); tv[i] = W[(size_t)(k0 + kk) * N + n0 + (lane & 31)]; }
#pragma unroll
    for (int i = 0; i < 32; ++i) { const int kk = 2 * i + (lane >> 5); scr[kk * 33 + (lane & 31)] = rs ? tv[i] * rs[k0 + kk] : tv[i]; }
    asm volatile("s_waitcnt lgkmcnt(0)" ::: "memory");
    const int c = lane & 7;
#pragma unroll
    for (int j = 0; j < 4; ++j) { const int n = (lane >> 3) + 8 * j; const LAS float* s = scr + (8 * c) * 33 + n;
        u32x4 o; o.x = cvt_pk_bf16(s[0 * 33], s[1 * 33]); o.y = cvt_pk_bf16(s[2 * 33], s[3 * 33]); o.z = cvt_pk_bf16(s[4 * 33], s[5 * 33]); o.w = cvt_pk_bf16(s[6 * 33], s[7 * 33]);
        const int dr = MAP ? in_dst_row(n0 + n) : (n0 + n);
        *(u32x4*)(WT + (size_t)dr * K + k0 + 8 * c) = o; }
    asm volatile("s_waitcnt lgkmcnt(0)" ::: "memory");
}
__device__ __forceinline__ void rms_row2_bf16(const float* xrow, const float* g, bf16_t* orow, int lane) {
    constexpr int NR = 4;
    f32x4 v[NR][8]; float s[NR];
#pragma unroll
    for (int r = 0; r < NR; ++r)
#pragma unroll
        for (int j = 0; j < 8; ++j) v[r][j] = *((const f32x4*)(xrow + (size_t)r * 2048) + 64 * j + lane);
    float rstd[NR];
#pragma unroll
    for (int r = 0; r < NR; ++r) { s[r] = 0.f;
#pragma unroll
        for (int j = 0; j < 8; ++j) s[r] += (v[r][j][0] * v[r][j][0] + v[r][j][1] * v[r][j][1]) + (v[r][j][2] * v[r][j][2] + v[r][j][3] * v[r][j][3]);
        rstd[r] = rsqrtf(wave_sum(s[r], lane) * (1.f / 2048.f) + EPS); }
#pragma unroll
    for (int j = 0; j < 8; ++j) { const f32x4 gg = *((const f32x4*)g + 64 * j + lane);
#pragma unroll
        for (int r = 0; r < NR; ++r) { const f32x4 y = v[r][j] * rstd[r] * gg; u32x2 o; o.x = cvt_pk_bf16(y[0], y[1]); o.y = cvt_pk_bf16(y[2], y[3]); *((u32x2*)(orow + (size_t)r * 2048) + 64 * j + lane) = o; } }
}

template <bool NORM, int ROT> __device__ __forceinline__ void rope_chunk(bf16_t* p, const u32x4 w, const f32x4 (&tb)[4], const float* g, float sc, int lane) {
    const int j = lane & 15;
    float x[8] = {bflo(w.x), bfhi(w.x), bflo(w.y), bfhi(w.y), bflo(w.z), bfhi(w.z), bflo(w.w), bfhi(w.w)};
    if (NORM) {
        float ss = 0.f;
#pragma unroll
        for (int q = 0; q < 8; ++q) ss += x[q] * x[q];
        ss = row16_sum(ss);
        const float rstd = rsqrtf(ss * (1.f / 128.f) + EPS);
        const f32x4 g0 = *(const f32x4*)(g + j * 8), g1 = *(const f32x4*)(g + j * 8 + 4);
#pragma unroll
        for (int q = 0; q < 4; ++q) { x[q] *= rstd * g0[q]; x[4 + q] *= rstd * g1[q]; }
    }
    constexpr int HALFL = ROT / 16;
    const bool rot = (ROT == 128) || (j < 8); const bool first = (j & HALFL) == 0;
    float o[8];
#pragma unroll
    for (int q = 0; q < 8; ++q) {
        const float other = (ROT == 128) ? DPPF(x[q], 0x128)   : shx(x[q], HALFL, lane);
        const float cs = tb[q >> 1][(q & 1) * 2], sn = tb[q >> 1][(q & 1) * 2 + 1];
        const float r = first ? (x[q] * cs - other * sn) : (x[q] * cs + other * sn);
        o[q] = (rot ? r : x[q]) * sc;
    }
    u32x4 ow; ow.x = cvt_pk_bf16(o[0], o[1]); ow.y = cvt_pk_bf16(o[2], o[3]); ow.z = cvt_pk_bf16(o[4], o[5]); ow.w = cvt_pk_bf16(o[6], o[7]);
    *(u32x4*)(p + lane * 8) = ow;
}
template <bool NORM, int ROT, bool PERTOK> __device__ __forceinline__ void rope_pass(bf16_t* base, int nchunks, const float* g, const float* tab, float sc, int gw, int NGW, int lane) {
    constexpr int NB = 8, HALFL = ROT / 16; const int j = lane & 15;
    for (int it0 = gw * NB; it0 < nchunks; it0 += NGW * NB) {
        u32x4 w[NB]; f32x4 tb[NB][4];
#pragma unroll
        for (int k = 0; k < NB; ++k) { const int it = it0 + k;
            w[k] = *(const u32x4*)(base + (size_t)it * 512 + lane * 8);
            const int pos = PERTOK ? ((it >> 2) & 8191) : (((it * 4) & 8191) + (lane >> 4));
            const float* tp = tab + (size_t)pos * ROT + (j & (HALFL - 1)) * 16;
#pragma unroll
            for (int q = 0; q < 4; ++q) tb[k][q] = *(const f32x4*)(tp + q * 4); }
#pragma unroll
        for (int k = 0; k < NB; ++k) rope_chunk<NORM, ROT>(base + (size_t)(it0 + k) * 512, w[k], tb[k], g, sc, lane);
    }
}
__device__ __forceinline__ void post_proj(const Args& A, int gw, int NGW, int lane) {
    unsigned char* ws = A.ws;
    const float* R1 = (const float*)(ws + WS_ROPE1); const float* R2 = (const float*)(ws + WS_ROPE2);
    const float qs = 0.08838834764831845f;
    rope_pass<true, 128, true>((bf16_t*)(ws + WS_DQ), T * 4, A.q_norm_g, R1, qs * 1.4426950408889634f  , gw, NGW, lane);
    rope_pass<true, 128, false>((bf16_t*)(ws + WS_DK), T, A.k_norm_g, R1, 1.f, gw, NGW, lane);
    rope_pass<false, 64, true>((bf16_t*)(ws + WS_IQ), T * 4, nullptr, R2, qs, gw, NGW, lane);
    rope_pass<true, 64, false>((bf16_t*)(ws + WS_IK), T / 4, A.idx_k_norm_g, R2, 1.f, gw, NGW, lane);
}

typedef float f32x16 __attribute__((ext_vector_type(16)));
__device__ __forceinline__ void idx_stream(unsigned char* ws, LAS unsigned char* lds, int bb, int bid, int G, int wave, int lane, int tid) {
    const bf16_t* IQ = (const bf16_t*)(ws + WS_IQ) + (size_t)bb * SEQ * 2048;
    const bf16_t* IK = (const bf16_t*)(ws + WS_IK) + (size_t)bb * SEQ * 128;
    const float* IW = (const float*)(ws + WS_IW) + (size_t)bb * SEQ * 16;
    _Float16* SC = (_Float16*)(ws + WS_SC);
    constexpr int NT = 8320, PITCH = 272, TK = 128;
    const int g0 = (int)(((long)bid * NT) / G), g1 = (int)(((long)(bid + 1) * NT) / G);
    if (g0 >= g1) return;
    int u = 0, pu = 0;
    while (pu + ((u + 4) >> 2) <= g0) { pu += (u + 4) >> 2; ++u; }
    const int rho = lane & 31, hi = lane >> 5, ha = rho >> 3, hb = (rho >> 2) & 1, hc = rho & 3;
    const int srow = tid >> 2, sseg = tid & 3;
    bf16x8 af[2][8]; float w[2][16];
    u32x4 st0, st1, st2, st3;
#define IDX_LOADA() do { _Pragma("unroll") for (int rt = 0; rt < 2; ++rt) { const int q = 32 * u + 4 * wave + 2 * rt; \
        const bf16_t* ap = IQ + (size_t)(q + hb) * 2048 + (4 * ha + hc) * 128 + 8 * hi; \
        _Pragma("unroll") for (int ks = 0; ks < 8; ++ks) af[rt][ks] = *(const bf16x8*)(ap + 16 * ks); \
        const f32x4* wp = (const f32x4*)(IW + (size_t)(q + hi) * 16); \
        _Pragma("unroll") for (int k4 = 0; k4 < 4; ++k4) { const f32x4 t4 = wp[k4]; w[rt][4 * k4] = t4[0]; w[rt][4 * k4 + 1] = t4[1]; w[rt][4 * k4 + 2] = t4[2]; w[rt][4 * k4 + 3] = t4[3]; } } } while (0)
#define IDX_LOADK(kt) do { const bf16_t* kp = IK + (size_t)((kt) * TK + srow) * 128 + sseg * 32; st0 = *(const u32x4*)kp; st1 = *(const u32x4*)(kp + 8); st2 = *(const u32x4*)(kp + 16); st3 = *(const u32x4*)(kp + 24); } while (0)
#define IDX_WRITEK(buf) do { LAS unsigned char* d = lds + (buf) * (TK * PITCH) + srow * PITCH + sseg * 64; *(LAS u32x4*)d = st0; *(LAS u32x4*)(d + 16) = st1; *(LAS u32x4*)(d + 32) = st2; *(LAS u32x4*)(d + 48) = st3; } while (0)
    IDX_LOADA();
    IDX_LOADK(g0 - pu); IDX_WRITEK(0);
    __syncthreads();
    for (int g = g0; g < g1; ++g) {
        const int kt = g - pu, buf = (g - g0) & 1;
        int un = u, pun = pu; if (g + 1 - pu >= ((u + 4) >> 2)) { pun = pu + ((u + 4) >> 2); un = u + 1; }
        if (g + 1 < g1) IDX_LOADK(g + 1 - pun);
        const LAS unsigned char* kb = lds + buf * (TK * PITCH) + rho * PITCH + hi * 16;
#pragma unroll
        for (int ct = 0; ct < TK / 32; ++ct) {
            bf16x8 bfr[8];
#pragma unroll
            for (int ks = 0; ks < 8; ++ks) bfr[ks] = *(const LAS bf16x8*)(kb + ct * 32 * PITCH + ks * 32);
            f32x16 c0, c1;
#pragma unroll
            for (int r = 0; r < 16; ++r) { c0[r] = 0.f; c1[r] = 0.f; }
#pragma unroll
            for (int ks = 0; ks < 8; ++ks) { c0 = __builtin_amdgcn_mfma_f32_32x32x16_bf16(af[0][ks], bfr[ks], c0, 0, 0, 0); c1 = __builtin_amdgcn_mfma_f32_32x32x16_bf16(af[1][ks], bfr[ks], c1, 0, 0, 0); }
            float s0 = 0.f, s1 = 0.f;
#pragma unroll
            for (int r = 0; r < 16; ++r) { s0 += w[0][r] * fmaxf(c0[r], 0.f); s1 += w[1][r] * fmaxf(c1[r], 0.f); }
            const int key = kt * TK + ct * 32 + rho, q = 32 * u + 4 * wave + hi;
            SC[(size_t)q * SEQ + key] = (_Float16)s0; SC[(size_t)(q + 2) * SEQ + key] = (_Float16)s1;
        }
        if (g + 1 < g1) IDX_WRITEK(buf ^ 1);
        if (un != u && g + 1 < g1) { u = un; pu = pun; IDX_LOADA(); }
        __syncthreads();
    }
#undef IDX_LOADA
#undef IDX_LOADK
#undef IDX_WRITEK
}

__device__ __forceinline__ void select_one(const unsigned short* sc, int t, unsigned short* idx, int lane, LAS unsigned short* li, LAS unsigned* hist) {
    if (t < 256) {
#pragma unroll
        for (int j = 0; j < 4; ++j) { const int i = j * 64 + lane; idx[i] = (unsigned short)(i <= t ? i : 0); }
        return;
    }
    unsigned key[128];
    const int ngrp = (t >> 9) + 1;
    u32x4 wv[16];
#pragma unroll
    for (int gI = 0; gI < 16; ++gI) wv[gI] = *(const u32x4*)(sc + gI * 512 + lane * 8);
#pragma unroll
    for (int gI = 0; gI < 16; ++gI) {
        const int s0 = gI * 512 + lane * 8; const u32x4 w = wv[gI];
#pragma unroll
        for (int q = 0; q < 8; ++q) { const unsigned wd = w[q >> 1]; const unsigned h = (q & 1) ? (wd >> 16) : (wd & 0xffffu);
            const unsigned k = (h & 0x8000u) ? (~h & 0xffffu) : (h | 0x8000u); key[gI * 8 + q] = (s0 + q <= t) ? k : 0u; }
    }
    unsigned thr = 0u; int ngt = 0;
    {
        const unsigned hbase = (unsigned)(size_t)hist;
        int above = 0; unsigned prefix = 0u;
#pragma unroll
        for (int pass = 0; pass < 2; ++pass) {
            *(LAS u32x4*)(hist + lane * 4) = (u32x4){0u, 0u, 0u, 0u};
            asm volatile("s_waitcnt lgkmcnt(0)" ::: "memory");
#pragma unroll
            for (int gI = 0; gI < 16; ++gI) if (gI < ngrp) {
#pragma unroll
                for (int q = 0; q < 8; ++q) { const unsigned k = key[gI * 8 + q];
                    const bool in = pass == 0 ? (k != 0u) : ((k >> 8) == prefix);
                    const unsigned bin = pass == 0 ? (k >> 8) : (k & 255u);
                    if (in) asm volatile("ds_add_u32 %0, %1" :: "v"(hbase + bin * 4u), "v"(1u) : "memory"); }
            }
            asm volatile("s_waitcnt lgkmcnt(0)" ::: "memory");
            const u32x4 h = *(const LAS u32x4*)(hist + lane * 4);
            const int sl = (int)(h.x + h.y + h.z + h.w), want = 256 - above;
            int run = 0, L = 63;
            for (; L > 0; --L) { const int v = __builtin_amdgcn_readlane(sl, L); if (run + v >= want) break; run += v; }
            int bin = 4 * L;
            { const int h3 = __builtin_amdgcn_readlane((int)h.w, L), h2 = __builtin_amdgcn_readlane((int)h.z, L), h1 = __builtin_amdgcn_readlane((int)h.y, L);
              if (run + h3 >= want) bin += 3; else { run += h3; if (run + h2 >= want) bin += 2; else { run += h2; if (run + h1 >= want) bin += 1; else run += h1; } } }
            above += run;
            if (pass == 0) prefix = (unsigned)bin; else thr = (prefix << 8) | (unsigned)bin;
        }
        ngt = above;
    }
    const int need = 256 - ngt; int bgt = 0, beq = 0;
#pragma unroll
    for (int gI = 0; gI < 16; ++gI) if (gI < ngrp) {
#pragma unroll
        for (int q = 0; q < 8; ++q) {
            const unsigned k = key[gI * 8 + q];
            const unsigned long long ms = __ballot(k >= thr);
            if (ms != 0ull) {
                const int s = gI * 512 + lane * 8 + q;
                const unsigned long long mg = __ballot(k > thr), me = ms & ~mg;
                const int rg = __builtin_amdgcn_mbcnt_hi((unsigned)(mg >> 32), __builtin_amdgcn_mbcnt_lo((unsigned)mg, 0u));
                const int re = __builtin_amdgcn_mbcnt_hi((unsigned)(me >> 32), __builtin_amdgcn_mbcnt_lo((unsigned)me, 0u));
                if (k > thr) li[bgt + rg] = (unsigned short)s;
                else if (k == thr && beq + re < need) li[ngt + beq + re] = (unsigned short)s;
                bgt += __popcll(mg); beq += __popcll(me);
            }
        }
    }
    asm volatile("s_waitcnt lgkmcnt(0)" ::: "memory");
    *(u32x2*)(idx + lane * 4) = *(const LAS u32x2*)(li + lane * 4);
}

__device__ __forceinline__ void attend_one(unsigned char* ws, LAS unsigned char* lds, int wave, int bb, int t, int kvh, int lane) {
    asm volatile("" : "+v"(lane));
    const int n = lane & 15, g = lane >> 4;
    const bf16_t* Kb = (const bf16_t*)(ws + WS_DK) + (size_t)(bb * 4 + kvh) * 8192 * 128;
    const bf16_t* Vb = (const bf16_t*)(ws + WS_DV) + (size_t)(bb * 4 + kvh) * 8192 * 128;
    bf16_t* qrow = (bf16_t*)(ws + WS_DQ) + (size_t)(bb * 8192 + t) * 2048 + kvh * 512;
    const unsigned short* ix = (const unsigned short*)(ws + WS_IDX) + (size_t)(bb * 8192 + t) * 256;
    const int cnt = t < 255 ? t + 1 : 256;
    LAS unsigned* li = (LAS unsigned*)(lds + wave * 1024);
    { const u32x2 iw = *(const u32x2*)(ix + lane * 4); *(LAS u32x4*)(li + lane * 4) = (u32x4){(iw.x & 0xffffu) << 8, (iw.x >> 16) << 8, (iw.y & 0xffffu) << 8, (iw.y >> 16) << 8}; }
    bf16x8 qf[4];
#pragma unroll
    for (int kk = 0; kk < 4; ++kk) { qf[kk] = (bf16x8){0, 0, 0, 0, 0, 0, 0, 0}; if (n < 4) qf[kk] = *(const bf16x8*)(qrow + n * 128 + kk * 32 + g * 8); }
    asm volatile("s_waitcnt vmcnt(0) lgkmcnt(0)" ::: "memory");
    bf16x8 ka[2][4][4];
#define ATT_LOADK(buf, grp) do { _Pragma("unroll") for (int tl = 0; tl < 4; ++tl) { const unsigned ko = li[((grp) * 4 + tl) * 16 + n] + (unsigned)g * 16u; \
        _Pragma("unroll") for (int kk = 0; kk < 4; ++kk) ka[buf][tl][kk] = *(const bf16x8*)((const char*)Kb + (ko + kk * 64u)); } } while (0)
    ATT_LOADK(0, 0); ATT_LOADK(1, 1);
    __builtin_amdgcn_sched_barrier(0);
    f32x4 S[16];
#pragma unroll
    for (int gi = 0; gi < 4; ++gi) {
#pragma unroll
        for (int tl = 0; tl < 4; ++tl) { f32x4 a = {0.f, 0.f, 0.f, 0.f};
#pragma unroll
            for (int kk = 0; kk < 4; ++kk) a = __builtin_amdgcn_mfma_f32_16x16x32_bf16(ka[gi & 1][tl][kk], qf[kk], a, 0, 0, 0);
            S[gi * 4 + tl] = a; }
        __builtin_amdgcn_sched_barrier(0);
        if (gi + 2 < 4) { ATT_LOADK(gi & 1, gi + 2); __builtin_amdgcn_sched_barrier(0); }
    }
#undef ATT_LOADK
    u32x4 R[3][8];
#define ATT_LOADV(buf, ks) do { const u32x4 i0 = *(const LAS u32x4*)(li + (ks) * 32 + 4 * g), i1 = *(const LAS u32x4*)(li + (ks) * 32 + 16 + 4 * g); \
        const unsigned kidx[8] = {i0.x, i0.y, i0.z, i0.w, i1.x, i1.y, i1.z, i1.w}; \
        _Pragma("unroll") for (int jj = 0; jj < 8; ++jj) R[buf][jj] = *(const u32x4*)((const char*)Vb + (kidx[jj] + (unsigned)n * 16u)); } while (0)
    ATT_LOADV(0, 0); ATT_LOADV(1, 1); ATT_LOADV(2, 2);
    __builtin_amdgcn_sched_barrier(0);
    if (cnt < 256) {
#pragma unroll
        for (int kt = 0; kt < 16; ++kt)
#pragma unroll
            for (int j = 0; j < 4; ++j) if (4 * g + j >= cnt - kt * 16) S[kt][j] = -3.0e38f;
    }
    float mx = -3.0e38f;
#pragma unroll
    for (int kt = 0; kt < 16; ++kt)
#pragma unroll
        for (int j = 0; j < 4; ++j) mx = fmaxf(mx, S[kt][j]);
    mx = fmaxf(mx, shx(mx, 16, lane)); mx = fmaxf(mx, shx(mx, 32, lane));
    float sum = 0.f;
#pragma unroll
    for (int kt = 0; kt < 16; ++kt)
#pragma unroll
        for (int j = 0; j < 4; ++j) { const float p = __builtin_amdgcn_exp2f(S[kt][j] - mx); S[kt][j] = p; sum += p; }
    sum += shx(sum, 16, lane); sum += shx(sum, 32, lane);
    const float inv = 1.f / sum;
    u32x4 pa[8];
#pragma unroll
    for (int ks = 0; ks < 8; ++ks) pa[ks] = pack8(S[2 * ks], S[2 * ks + 1]);
    f32x4 O[8];
#pragma unroll
    for (int dt = 0; dt < 8; ++dt) O[dt] = (f32x4){0.f, 0.f, 0.f, 0.f};
    __builtin_amdgcn_sched_barrier(0);
#pragma unroll
    for (int ks = 0; ks < 8; ++ks) {
        const bf16x8 pk = __builtin_bit_cast(bf16x8, pa[ks]);
#pragma unroll
        for (int w = 0; w < 4; ++w) {
            u32x4 lo, hi;
#pragma unroll
            for (int a = 0; a < 4; ++a) { lo[a] = __builtin_amdgcn_perm(R[ks % 3][2 * a + 1][w], R[ks % 3][2 * a][w], 0x05040100u); hi[a] = __builtin_amdgcn_perm(R[ks % 3][2 * a + 1][w], R[ks % 3][2 * a][w], 0x07060302u); }
            O[2 * w] = __builtin_amdgcn_mfma_f32_16x16x32_bf16(pk, __builtin_bit_cast(bf16x8, lo), O[2 * w], 0, 0, 0);
            O[2 * w + 1] = __builtin_amdgcn_mfma_f32_16x16x32_bf16(pk, __builtin_bit_cast(bf16x8, hi), O[2 * w + 1], 0, 0, 0);
        }
        __builtin_amdgcn_sched_barrier(0);
        if (ks + 3 < 8) { ATT_LOADV(ks % 3, ks + 3); __builtin_amdgcn_sched_barrier(0); }
    }
#undef ATT_LOADV
#pragma unroll
    for (int j = 0; j < 4; ++j) {
        const float iv = __int_as_float(__builtin_amdgcn_readlane(__float_as_int(inv), j));
        if (g == 0) { f32x4 a = {O[0][j] * iv, O[1][j] * iv, O[2][j] * iv, O[3][j] * iv}, b = {O[4][j] * iv, O[5][j] * iv, O[6][j] * iv, O[7][j] * iv};
            st8bf(qrow + j * 128 + n * 8, a, b); }
    }
}

__device__ __forceinline__ float log_a_of(const LAS float* glr, const float (&w)[16], float bgc) {
    float z = bgc;
    const f32x4 g0 = *(const LAS f32x4*)glr, g1 = *(const LAS f32x4*)(glr + 4), g2 = *(const LAS f32x4*)(glr + 8), g3 = *(const LAS f32x4*)(glr + 12);
#pragma unroll
    for (int k = 0; k < 4; ++k) z += g0[k] * w[k] + g1[k] * w[4 + k] + g2[k] * w[8 + k] + g3[k] * w[12 + k];
    return -(fmaxf(-z, 0.f) + __logf(1.f + __expf(-fabsf(z)))) * 0.0625f;
}
__device__ __forceinline__ void gla_prep(const Args& A, LAS float* sm, int uu, int tid) {
    unsigned char* ws = A.ws;
    const int ch = tid & 255, half = __builtin_amdgcn_readfirstlane(tid >> 8);
    const int c = uu & 31, h = (uu >> 5) & 3, b = uu >> 7;
    const int tok0 = b * 8192 + c * 256 + half * 128;
    float w[16];
#pragma unroll
    for (int k = 0; k < 16; ++k) w[k] = A.gla_wg2[k * 1024 + h * 256 + ch];
    const float bgc = A.gla_bg[h * 256 + ch];
    {
        const f32x4* src = (const f32x4*)((const float*)(ws + WS_GLR) + (size_t)(b * 8192 + c * 256) * 16);
        LAS f32x4* dst = (LAS f32x4*)(sm + 1024);
        dst[tid] = src[tid]; dst[tid + 512] = src[tid + 512];
    }
    __syncthreads();
    const LAS float* GLR = sm + 1024 + half * 128 * 16;
    float s = 0.f;
#pragma unroll 4
    for (int tt = 0; tt < 128; ++tt) s += log_a_of(GLR + tt * 16, w, bgc);
    sm[half * 256 + ch] = s;
    __syncthreads();
    const float tot0 = sm[ch], blast = sm[ch] + sm[256 + ch];
    __syncthreads();
    if (half == 0) ((float*)(ws + WS_BLAST))[uu * 256 + ch] = blast;
    float bcur = half ? tot0 : 0.f;
    const bf16_t* GQ = (const bf16_t*)(ws + WS_GQ); bf16_t* GK = (bf16_t*)(ws + WS_GK);
    bf16_t* QS = (bf16_t*)(ws + WS_QS) + (size_t)uu * 256 * 256; bf16_t* KT = (bf16_t*)(ws + WS_KT) + ((size_t)uu * 256 + ch) * 256 + half * 128;
    unsigned short qn[8], kn[8];
#pragma unroll
    for (int q = 0; q < 8; ++q) { const size_t o = (size_t)(tok0 + q) * 1024 + h * 256 + ch; qn[q] = GQ[o]; kn[q] = GK[o]; }
    for (int t8 = 0; t8 < 16; ++t8) {
        float kp[8], qv[8], kv[8];
#pragma unroll
        for (int q = 0; q < 8; ++q) { qv[q] = bf2f(qn[q]); kv[q] = bf2f(kn[q]); }
        if (t8 < 15) {
#pragma unroll
            for (int q = 0; q < 8; ++q) { const size_t o = (size_t)(tok0 + (t8 + 1) * 8 + q) * 1024 + h * 256 + ch; qn[q] = GQ[o]; kn[q] = GK[o]; }
        }
#pragma unroll
        for (int q = 0; q < 8; ++q) {
            const int tt = t8 * 8 + q; const size_t tok = (size_t)(tok0 + tt);
            bcur += log_a_of(GLR + tt * 16, w, bgc);
            const float eb = __expf(bcur), ieb = __expf(-bcur);
            QS[(size_t)(half * 128 + tt) * 256 + ch] = f2bf(qv[q] * eb);
            kp[q] = kv[q] * ieb;
            GK[tok * 1024 + h * 256 + ch] = f2bf(kp[q]);
        }
        u32x4 o; o.x = cvt_pk_bf16(kp[0], kp[1]); o.y = cvt_pk_bf16(kp[2], kp[3]); o.z = cvt_pk_bf16(kp[4], kp[5]); o.w = cvt_pk_bf16(kp[6], kp[7]);
        *(u32x4*)(KT + t8 * 8) = o;
    }
}
__device__ __forceinline__ void gla_scan(unsigned char* ws, int gt, int NGT) {
    const float* BL = (const float*)(ws + WS_BLAST);
    for (int it = gt; it < 8 * 512 * 32; it += NGT) {
        const int d8 = it & 31, e = (it >> 5) & 511, bh = it >> 14;
        float S[8];
#pragma unroll
        for (int q = 0; q < 8; ++q) S[q] = 0.f;
        for (int c0 = 0; c0 < 32; c0 += 4) {
            u32x4 uw[4]; f32x4 d0[4], d1[4];
#pragma unroll
            for (int k = 0; k < 4; ++k) { const int uu = bh * 32 + c0 + k;
                uw[k] = *(const u32x4*)((const bf16_t*)(ws + WS_ST) + ((size_t)uu * 512 + e) * 256 + d8 * 8);
                d0[k] = *(const f32x4*)(BL + uu * 256 + d8 * 8); d1[k] = *(const f32x4*)(BL + uu * 256 + d8 * 8 + 4); }
#pragma unroll
            for (int k = 0; k < 4; ++k) { const int uu = bh * 32 + c0 + k;
                u32x4 o; o.x = cvt_pk_bf16(S[0], S[1]); o.y = cvt_pk_bf16(S[2], S[3]); o.z = cvt_pk_bf16(S[4], S[5]); o.w = cvt_pk_bf16(S[6], S[7]);
                *(u32x4*)((bf16_t*)(ws + WS_ST) + ((size_t)uu * 512 + e) * 256 + d8 * 8) = o;
                S[0] = S[0] * __expf(d0[k][0]) + bflo(uw[k].x); S[1] = S[1] * __expf(d0[k][1]) + bfhi(uw[k].x); S[2] = S[2] * __expf(d0[k][2]) + bflo(uw[k].y); S[3] = S[3] * __expf(d0[k][3]) + bfhi(uw[k].y);
                S[4] = S[4] * __expf(d1[k][0]) + bflo(uw[k].z); S[5] = S[5] * __expf(d1[k][1]) + bfhi(uw[k].z); S[6] = S[6] * __expf(d1[k][2]) + bflo(uw[k].w); S[7] = S[7] * __expf(d1[k][3]) + bfhi(uw[k].w); }
        }
    }
}
__device__ __forceinline__ void gla_post(const Args& A, int gw, int NGW, int lane) {
    unsigned char* ws = A.ws;
    const f32x4 g0 = *(const f32x4*)(A.gla_norm_g + lane * 8), g1 = *(const f32x4*)(A.gla_norm_g + lane * 8 + 4);
    for (int it0 = gw * 4; it0 < T * 4; it0 += NGW * 4) {
        u32x4 xw[4], gw4[4];
#pragma unroll
        for (int k = 0; k < 4; ++k) { const int it = it0 + k; const size_t o = (size_t)(it >> 2) * 2048 + (it & 3) * 512 + lane * 8;
            xw[k] = *(const u32x4*)((const bf16_t*)(ws + WS_OG) + o); gw4[k] = *(const u32x4*)((const bf16_t*)(ws + WS_GR) + o); }
#pragma unroll
        for (int k = 0; k < 4; ++k) { const int it = it0 + k; const size_t o = (size_t)(it >> 2) * 2048 + (it & 3) * 512 + lane * 8;
            f32x4 x0 = {bflo(xw[k].x), bfhi(xw[k].x), bflo(xw[k].y), bfhi(xw[k].y)}, x1 = {bflo(xw[k].z), bfhi(xw[k].z), bflo(xw[k].w), bfhi(xw[k].w)};
            const f32x4 r0 = {bflo(gw4[k].x), bfhi(gw4[k].x), bflo(gw4[k].y), bfhi(gw4[k].y)}, r1 = {bflo(gw4[k].z), bfhi(gw4[k].z), bflo(gw4[k].w), bfhi(gw4[k].w)};
            float ss = 0.f;
#pragma unroll
            for (int q = 0; q < 4; ++q) ss += x0[q] * x0[q] + x1[q] * x1[q];
            const float rstd = rsqrtf(wave_sum(ss, lane) * (1.f / 512.f) + EPS);
            x0 = x0 * rstd * g0 * r0; x1 = x1 * rstd * g1 * r1;
            *(u32x4*)((bf16_t*)(ws + WS_OG) + o) = pack8(x0, x1); }
    }
}

#define XB_TMO      128
#define XB_XCNT(j)  (256  + 64 * (j))
#define XB_XSUB(j)  (1280 + 64 * (j))
#define XB_XGEN(j)  (2304 + 64 * (j))
#define XB_TOP      3328
#define XB_TOPGEN   3392
#define XCD_BAR_WORDS 3456
#define XB_SPIN_CAP (1u << 22)
#define RLX_AGENT __ATOMIC_RELAXED, __HIP_MEMORY_SCOPE_AGENT
__device__ __forceinline__ unsigned xb_ld(unsigned* p)              { return __hip_atomic_load(p, RLX_AGENT); }
__device__ __forceinline__ unsigned xb_add(unsigned* p, unsigned v) { return __hip_atomic_fetch_add(p, v, RLX_AGENT); }
__device__ __forceinline__ unsigned xb_xcc_id() { return (unsigned)__builtin_amdgcn_s_getreg((3 << 11) | 20) & 0xFu; }
#define XB_SPIN(cond, bar) do { unsigned _sp = 0; while (cond) { __builtin_amdgcn_s_sleep(1); \
    if ((++_sp & 255u) == 0u) { if (xb_ld(&(bar)[XB_TMO])) break; if (_sp > XB_SPIN_CAP) { atomicAdd(&(bar)[XB_TMO], 1u); break; } } } } while (0)
__device__ __forceinline__ void xcd_barrier_complete(unsigned* bar, unsigned x, unsigned G, unsigned& nloc, unsigned& nx) {
    unsigned sum, cnt, mine, sp = 0u;
    for (;;) {
        sum = 0u; cnt = 0u; mine = 0u;
#pragma unroll
        for (unsigned j = 0; j < 16; ++j) { const unsigned c = xb_ld(&bar[XB_XCNT(j)]); sum += c; cnt += (c > 0u) ? 1u : 0u; mine = (j == x) ? c : mine; }
        if (sum == G) break;
        __builtin_amdgcn_s_sleep(1);
        if ((++sp & 255u) == 0u) { if (xb_ld(&bar[XB_TMO])) break; if (sp > XB_SPIN_CAP) { atomicAdd(&bar[XB_TMO], 1u); break; } }
    }
    nloc = mine > 0u ? mine : 1u; nx = cnt > 0u ? cnt : 1u;
}
__device__ __forceinline__ void grid_bar(unsigned* bar, volatile LAS unsigned* st, unsigned G, int wave) {
    asm volatile("s_waitcnt vmcnt(0) lgkmcnt(0)" ::: "memory");
    __syncthreads();
    int l; asm volatile("v_mbcnt_lo_u32_b32 %0, -1, 0\n\tv_mbcnt_hi_u32_b32 %0, -1, %0" : "=v"(l));
    if (wave == 0 && l == 0) {
        const unsigned x = xb_xcc_id();
        __builtin_amdgcn_s_waitcnt(0);
        unsigned nloc = st[0], nx = st[1];
        if (nloc == 0u) { xcd_barrier_complete(bar, x, G, nloc, nx); st[0] = nloc; st[1] = nx; }
        const unsigned old = xb_add(&bar[XB_XSUB(x)], 1u);
        const unsigned gen = old / nloc;
        if (old + 1u == (gen + 1u) * nloc) {
            __builtin_amdgcn_fence(__ATOMIC_RELEASE, "agent");
            asm volatile("s_waitcnt vmcnt(0)" ::: "memory");
            const unsigned og = xb_add(&bar[XB_TOP], 1u);
            const unsigned tg = og / nx;
            if (og + 1u == (tg + 1u) * nx) xb_add(&bar[XB_TOPGEN], 1u);
            else XB_SPIN(xb_ld(&bar[XB_TOPGEN]) == tg, bar);
            __builtin_amdgcn_fence(__ATOMIC_ACQUIRE, "agent");
            xb_add(&bar[XB_XGEN(x)], 1u);
            asm volatile("s_waitcnt vmcnt(0)" ::: "memory");
        } else {
            XB_SPIN(xb_ld(&bar[XB_XGEN(x)]) == gen, bar);
            __builtin_amdgcn_fence(__ATOMIC_ACQUIRE, "agent");
            asm volatile("s_waitcnt vmcnt(0)" ::: "memory");
        }
    }
    __syncthreads();
}
__device__ __forceinline__ Args load_args() {
    Args a{};
#if defined(__HIP_DEVICE_COMPILE__)
    const __attribute__((address_space(4))) unsigned long long* q = (const __attribute__((address_space(4))) unsigned long long*)__builtin_amdgcn_kernarg_segment_ptr();
    asm volatile("" : "+s"(q));
    unsigned long long* d = (unsigned long long*)&a;
#pragma unroll
    for (int i = 0; i < (int)(sizeof(Args) / 8); ++i) d[i] = q[i];
#endif
    return a;
}
__global__ void __launch_bounds__(512, 2) hybrid_fwd(Args A0) {
    extern __shared__ __attribute__((aligned(16))) unsigned char lds_raw[];
    LAS unsigned char* lds = (LAS unsigned char*)lds_raw;
    cg::grid_group grid = cg::this_grid();
    unsigned char* ws = A0.ws; const int ph_lo = A0.ph_lo, ph_hi = A0.ph_hi;
    const int G = gridDim.x, bid = blockIdx.x;
    const int NGW = G * 8;
    const int wave = __builtin_amdgcn_readfirstlane(threadIdx.x >> 6);
    const Gemm gws{(const bf16_t*)ws, (const bf16_t*)ws, 256, 256, 256};
    int ph = 0;
    volatile LAS unsigned* bst = (volatile LAS unsigned*)(lds + 131072);
    { int l0; asm volatile("v_mbcnt_lo_u32_b32 %0, -1, 0\n\tv_mbcnt_hi_u32_b32 %0, -1, %0" : "=v"(l0));
      if (wave == 0 && l0 == 0) { const unsigned x0 = xb_xcc_id(); bst[0] = 0u; bst[1] = 0u; bst[3] = x0; bst[2] = xb_add(&((unsigned*)ws)[XB_XCNT(x0)], 1u); } }
    grid.sync();
#ifndef PHMASK
#define PHMASK 0xffffffffu
#endif
#define PHASE_BEGIN(id) if (((PHMASK >> (id)) & 1u) && ph >= ph_lo && ph < ph_hi) { const Args A = load_args(); int lane; asm volatile("v_mbcnt_lo_u32_b32 %0, -1, 0\n\tv_mbcnt_hi_u32_b32 %0, -1, %0" : "=v"(lane)); const int tid = wave * 64 + lane, gw = bid * 8 + wave; (void)tid; LAS float* scr = (LAS float*)(lds + wave * 16384); (void)lane; (void)gw; (void)scr;
#define PHASE_END_NOBAR } ++ph; __syncthreads();
#define PHASE_END } ++ph; if (ph > ph_lo && ph < ph_hi) { grid_bar((unsigned*)ws, bst, (unsigned)G, wave); }

    PHASE_BEGIN(0)
        for (int it = gw; it < 32 * (NPROJ / 32); it += NGW) transpose_item<true>(A.w_in, DM, NPROJ, (bf16_t*)(ws + WS_WTIN), scr, it, lane);
        for (int m = gw * 4; m < T; m += NGW * 4) rms_row2_bf16(A.x + (size_t)m * DM, A.norm1_g, (bf16_t*)(ws + WS_H) + (size_t)m * DM, lane);
        for (int i = bid * 512 + tid; i < T; i += G * 512) ((float*)(ws + WS_RSS))[i] = 0.f;
        for (int i = bid * 512 + tid; i < SEQ * 96; i += G * 512) {
            const int pos = i / 96, j = i % 96;
            if (j < 64) { const float f = powf(10000.f, -(float)j * 2.0f / 128.f); const float a = (float)pos * f; float sn, cs; sincosf(a, &sn, &cs);
                ((float*)(ws + WS_ROPE1))[(size_t)pos * 128 + j * 2] = cs; ((float*)(ws + WS_ROPE1))[(size_t)pos * 128 + j * 2 + 1] = sn; }
            else { const int jj = j - 64; const float f = powf(10000.f, -(float)jj * 2.0f / 64.f); const float a = (float)pos * f; float sn, cs; sincosf(a, &sn, &cs);
                ((float*)(ws + WS_ROPE2))[(size_t)pos * 64 + jj * 2] = cs; ((float*)(ws + WS_ROPE2))[(size_t)pos * 64 + jj * 2 + 1] = sn; }
        }
    PHASE_END
    PHASE_BEGIN(1)
        const Gemm g{(const bf16_t*)(ws + WS_H), (const bf16_t*)(ws + WS_WTIN), DM, DM, DM};
        pg8::StaticOrder S; S.init(T, NPROJ_PAD, DM, DM, G, bid);
        Epi<M_INPROJ> E{&A, 0};
        pg8::gemm_phase<Epi<M_INPROJ>, pg8::StaticOrder, true>(lds, g, S, E, wave);
    PHASE_END
    PHASE_BEGIN(2)
        post_proj(A, gw, NGW, lane);
    PHASE_END
#define DSA_ROUND(bb, ATT_END) \
        PHASE_BEGIN(3) \
            idx_stream(ws, lds, bb, bid, G, wave, lane, tid); \
        PHASE_END \
        PHASE_BEGIN(4) \
            for (int t = gw; t < SEQ; t += NGW) \
                select_one((const unsigned short*)(ws + WS_SC) + (size_t)t * SEQ, t, (unsigned short*)(ws + WS_IDX) + (size_t)(bb * SEQ + t) * 256, lane, (LAS unsigned short*)(lds + wave * 512), (LAS unsigned*)(lds + 4096 + wave * 1024)); \
        PHASE_END \
        PHASE_BEGIN(5) \
            const bool xl = (G == 256) && bst[0] == 32u && bst[1] == 8u && bst[3] < 8u; const int xq = (int)bst[3], kvh0 = xq & 3, qh = (xq >> 2) & 1, lw = (int)bst[2] * 8 + wave; \
            for (int it = gw, k = 0; xl ? (k < 16) : (it < SEQ * 4); it += NGW, ++k) attend_one(ws, lds, wave, bb, xl ? (lw + 256 * k) * 2 + qh : (it >> 2), xl ? kvh0 : (it & 3), lane); \
        ATT_END
    DSA_ROUND(0, PHASE_END_NOBAR)
    DSA_ROUND(1, PHASE_END)
#undef DSA_ROUND
    PHASE_BEGIN(6)
        for (int uu = bid; uu < 256; uu += G) { gla_prep(A, (LAS float*)lds, uu, tid); __syncthreads(); }
    PHASE_END
    PHASE_BEGIN(7)
        { G0Order S{G, bid}; Epi<M_G0> E{&A, 0}; pg8::gemm_phase<Epi<M_G0>, G0Order, true>(lds, gws, S, E, wave); }
        { Gemm g1 = gws; g1.lda = 256; g1.ldb = 1024; G1Order S{G, bid}; Epi<M_G1> E{&A, 0}; pg8::gemm_phase<Epi<M_G1>, G1Order, true>(lds, g1, S, E, wave); }
    PHASE_END
    PHASE_BEGIN(8)
        gla_scan(ws, bid * 512 + tid, G * 512);
    PHASE_END
    PHASE_BEGIN(9)
        G2Order S{G, bid}; Epi<M_G2> E{&A, 0}; pg8::gemm_phase<Epi<M_G2>, G2Order, true>(lds, gws, S, E, wave);
    PHASE_END
    PHASE_BEGIN(10)
        gla_post(A, gw, NGW, lane);
        constexpr int I_P = 32 * 64, I_F = 32 * 256;
        for (int it = gw; it < 3 * I_P + 2 * I_F; it += NGW) {
            int r = it;
            if (r < I_P) { transpose_item<false>(A.w_proj_gla, 2048, 2048, (bf16_t*)(ws + WS_WPG), scr, r, lane); continue; } r -= I_P;
            if (r < I_P) { transpose_item<false>(A.w_proj_dsa, 2048, 2048, (bf16_t*)(ws + WS_WPD), scr, r, lane); continue; } r -= I_P;
            if (r < I_P) { transpose_item<false>(A.w_out, 2048, 2048, (bf16_t*)(ws + WS_WO), scr, r, lane); continue; } r -= I_P;
            if (r < I_F) { transpose_item<false>(A.w_ff1, 2048, 8192, (bf16_t*)(ws + WS_WF1), scr, r, lane, A.norm2_g); continue; }     r -= I_F;
            transpose_item<false>(A.w_ff2, 8192, 2048, (bf16_t*)(ws + WS_WF2), scr, r, lane);
        }
    PHASE_END
    PHASE_BEGIN(11)
        Gemm g = gws; g.lda = 2048; g.ldb = 2048; g.K = 2048;
        MergeOrder S; S.so.init(T, DM, DM, DM, G, bid); Epi<M_MERGE> E{&A, 0};
        pg8::gemm_phase<Epi<M_MERGE>, MergeOrder, true>(lds, g, S, E, wave);
    PHASE_END
    PHASE_BEGIN(12)
        const Gemm g{(const bf16_t*)(ws + WS_U), (const bf16_t*)(ws + WS_WO), DM, DM, DM};
        pg8::StaticOrder S; S.init(T, DM, DM, DM, G, bid); Epi<M_OUT> E{&A, 0};
        pg8::gemm_phase<Epi<M_OUT>, pg8::StaticOrder, true>(lds, g, S, E, wave);
    PHASE_END
    PHASE_BEGIN(14)
        const Gemm g{(const bf16_t*)(ws + WS_H2), (const bf16_t*)(ws + WS_WF1), DM, DM, DM};
        pg8::StaticOrder S; S.init(T, DFF, DM, DM, G, bid); Epi<M_FF1> E{&A, 0};
        pg8::gemm_phase<Epi<M_FF1>, pg8::StaticOrder, true>(lds, g, S, E, wave);
    PHASE_END
    PHASE_BEGIN(15)
        const Gemm g{(const bf16_t*)(ws + WS_HM), (const bf16_t*)(ws + WS_WF2), DFF, DFF, DFF};
        pg8::StaticOrder S; S.init(T, DM, DFF, DFF, G, bid); Epi<M_FF2> E{&A, 0};
        pg8::gemm_phase<Epi<M_FF2>, pg8::StaticOrder, true>(lds, g, S, E, wave);
    PHASE_END
}

constexpr int LDS_BYTES = 131072 + 4096;
extern "C" void kernel_launch(void* const* d_in, const int* in_sizes, int n_in, void* d_out, int out_size, void* d_ws, size_t ws_size, hipStream_t stream) {
    static int grid = 0;
    if (grid == 0) {
        if (n_in != 16 || ws_size < WS_NEED) { fprintf(stderr, "kernel_launch: need 16 inputs and >= %zu bytes of workspace (got %d, %zu)\n", (size_t)WS_NEED, n_in, ws_size); grid = -1; return; }
        int dev = 0, cus = 0, per_cu = 0;
        hipGetDevice(&dev); hipDeviceGetAttribute(&cus, hipDeviceAttributeMultiprocessorCount, dev);
        if (hipFuncSetAttribute((const void*)hybrid_fwd, hipFuncAttributeMaxDynamicSharedMemorySize, LDS_BYTES) != hipSuccess) { fprintf(stderr, "kernel_launch: hipFuncSetAttribute failed\n"); grid = -1; return; }
        if (hipOccupancyMaxActiveBlocksPerMultiprocessor(&per_cu, (const void*)hybrid_fwd, 512, LDS_BYTES) != hipSuccess || per_cu < 1) { fprintf(stderr, "kernel_launch: occupancy query gave %d\n", per_cu); per_cu = 1; }
        (void)hipGetLastError();
        grid = cus * 1;
    }
    if (grid < 0) return;
    Args a{};
    const float** f = (const float**)&a;
    for (int i = 0; i < 16; ++i) f[i] = (const float*)d_in[i];
    a.out = (float*)d_out; a.ws = (unsigned char*)d_ws; a.ph_lo = 0; a.ph_hi = 1000;
    if (hipMemsetAsync(d_ws, 0, 16384, stream) != hipSuccess) { fprintf(stderr, "kernel_launch: memset failed\n"); return; }
    void* args[] = {&a};
    hipError_t e = hipLaunchCooperativeKernel((const void*)hybrid_fwd, dim3(grid), dim3(512), args, LDS_BYTES, stream);
    if (e != hipSuccess) fprintf(stderr, "cooperative launch failed: %s (grid %d)\n", hipGetErrorString(e), grid);
}
```

```cpp
#include <hip/hip_runtime.h>
#include <hip/hip_cooperative_groups.h>
#include <cstdio>
#include <cstdint>
namespace cg = cooperative_groups;

#define LAS __attribute__((address_space(3)))
typedef unsigned short bf16_t;
typedef short bf16x8 __attribute__((ext_vector_type(8)));
typedef float f32x4 __attribute__((ext_vector_type(4)));
typedef unsigned u32x4 __attribute__((ext_vector_type(4)));
typedef unsigned u32x2 __attribute__((ext_vector_type(2)));

constexpr int T = 16384, SEQ = 8192, DM = 2048, DFF = 8192, NPROJ = 15520, NPROJ_PAD = 15616;
constexpr float EPS = 1e-6f;
constexpr size_t MiB = 1u << 20;
constexpr size_t WS_GLR = 1 * MiB, WS_IW = 2 * MiB, WS_BLAST = 3 * MiB, WS_ROPE1 = 4 * MiB, WS_ROPE2 = 8 * MiB, WS_IK = 10 * MiB, WS_IDX = 14 * MiB, WS_CNT = 22 * MiB;
constexpr size_t WS_GQ = 24 * MiB, WS_GK = 56 * MiB, WS_VT = 88 * MiB, WS_GR = 152 * MiB, WS_DQ = 216 * MiB, WS_DK = 280 * MiB, WS_DV = 296 * MiB, WS_IQ = 312 * MiB;
constexpr size_t WS_WTIN = 376 * MiB, WS_H = 437 * MiB;
constexpr size_t WS_SC = 376 * MiB;
constexpr size_t WS_QS = 280 * MiB, WS_P = 312 * MiB, WS_ST = 344 * MiB, WS_KT = 408 * MiB, WS_OG = 440 * MiB;
constexpr size_t WS_WPG = 24 * MiB, WS_WPD = 32 * MiB, WS_WO = 40 * MiB, WS_WF1 = 48 * MiB, WS_WF2 = 80 * MiB;
constexpr size_t WS_U = 280 * MiB, WS_H2 = 440 * MiB, WS_HM = 112 * MiB;
constexpr size_t WS_RSS = 22 * MiB;
constexpr size_t WS_NEED = 512 * MiB;

__device__ __forceinline__ unsigned cvt_pk_bf16(float lo, float hi) { unsigned r; asm volatile("v_cvt_pk_bf16_f32 %0, %1, %2" : "=v"(r) : "v"(lo), "v"(hi)); return r; }
__device__ __forceinline__ float bf2f(unsigned short b) { return __uint_as_float(((unsigned)b) << 16); }
__device__ __forceinline__ float bflo(unsigned w) { return __uint_as_float(w << 16); }
__device__ __forceinline__ float bfhi(unsigned w) { return __uint_as_float(w & 0xffff0000u); }
__device__ __forceinline__ unsigned short f2bf(float f) { return (unsigned short)(cvt_pk_bf16(f, 0.f) & 0xffffu); }
__device__ __forceinline__ float shx(float v, int m, int lane) { return __int_as_float(__builtin_amdgcn_ds_bpermute((lane ^ m) << 2, __float_as_int(v))); }
#define DPPF(v, ctrl) __int_as_float(__builtin_amdgcn_update_dpp(0, __float_as_int(v), (ctrl), 0xf, 0xf, false))
__device__ __forceinline__ float row16_sum(float x) { x += DPPF(x, 0xB1); x += DPPF(x, 0x4E); x += DPPF(x, 0x141); x += DPPF(x, 0x140); return x; }
__device__ __forceinline__ float wave_sum(float v, int lane) {
    (void)lane; const float x = row16_sum(v);
    return (__int_as_float(__builtin_amdgcn_readlane(__float_as_int(x), 0)) + __int_as_float(__builtin_amdgcn_readlane(__float_as_int(x), 16)))
         + (__int_as_float(__builtin_amdgcn_readlane(__float_as_int(x), 32)) + __int_as_float(__builtin_amdgcn_readlane(__float_as_int(x), 48)));
}
__device__ __forceinline__ u32x4 pack8(f32x4 a, f32x4 b) { u32x4 w; w.x = cvt_pk_bf16(a[0], a[1]); w.y = cvt_pk_bf16(a[2], a[3]); w.z = cvt_pk_bf16(b[0], b[1]); w.w = cvt_pk_bf16(b[2], b[3]); return w; }

namespace pg8 {
constexpr int BM = 256, BK = 64, HALF = 128, HTB = HALF * BK * 2, STAGE_BYTES = 8 * HTB, NXCD = 8, WGM = 8;
__host__ __device__ __forceinline__ int lds_byte(int r, int c) { const int st = (r >> 4) * 2 + (c >> 5), rr = r & 15, cc = c & 31, ob = rr * 64 + cc * 2; return st * 1024 + (ob ^ (((ob >> 9) & 1) << 5)); }
__host__ __device__ __forceinline__ void stage_rc(int b, int& R, int& C) { const int st = b / 1024, sb = b % 1024, swz = sb ^ (((sb >> 9) & 1) << 5); R = (st >> 1) * 16 + swz / 64; C = (st & 1) * 32 + (swz % 64) / 2; }
__host__ __device__ __forceinline__ int perm32(int rho) { const int n = rho >> 4, i = rho & 15; return 8 * (i >> 2) + 4 * n + (i & 3); }

__device__ __forceinline__ void glds16s(const void* sbase, unsigned voff, unsigned lds_dst) { unsigned keep;
    asm volatile("s_mov_b32 %0, m0\n\ts_mov_b32 m0, %3\n\ts_nop 0\n\tglobal_load_lds_dwordx4 %1, %2\n\ts_mov_b32 m0, %0" : "=&s"(keep) : "v"(voff), "s"(sbase), "s"(lds_dst) : "memory"); }
struct Unit { int pm, pn; long offA, offB; int chain, aux; };
struct Gemm { const bf16_t* A; const bf16_t* Bt; int lda, ldb, K; };

struct StaticOrder {
    int nM, nN, nwg, G, c; long sA, sB;
    __device__ void init(int M, int N, int lda, int ldb, int G_, int c_) { nM = M / BM; nN = N / BM; nwg = nM * nN; G = G_; c = c_; sA = (long)BM * lda * 2; sB = (long)BM * ldb * 2; }
    __device__ bool next(int i, Unit& u) const {
        const long L = (long)i * G + c; if (L >= nwg) return false;
        int wgid = (int)L; { const int q = nwg / NXCD, r = nwg % NXCD, xcd = wgid % NXCD, off = wgid / NXCD; wgid = (xcd < r ? xcd * (q + 1) : r * (q + 1) + (xcd - r) * q) + off; }
        const int nig = WGM * nN, gid = wgid / nig, fm = gid * WGM, gsz = (nM - fm) < WGM ? (nM - fm) : WGM;
        u.pm = fm + ((wgid % nig) % gsz); u.pn = (wgid % nig) / gsz; u.offA = u.pm * sA; u.offB = u.pn * sB; u.chain = 0; u.aux = 0; return true;
    }
};

template <class Epi, class Sched, bool ALIGN_EPI>
__device__ __forceinline__ void gemm_phase(LAS unsigned char* lds, const Gemm g, const Sched& S, const Epi& E, int wid) {
    int lane; asm volatile("v_mbcnt_lo_u32_b32 %0, -1, 0\n\tv_mbcnt_hi_u32_b32 %0, -1, %0" : "=v"(lane));
    const int tid = wid * 64 + lane; const int wr = wid >> 2, wc = wid & 3, fr = lane & 15, fq = lane >> 4;
    const int K = g.K, nt = K / BK;
    unsigned voffA[2], voffB[2];
#pragma unroll
    for (int i = 0; i < 2; ++i) { int R, C; stage_rc(tid * 16 + i * 8192, R, C); const int Rb = (R & ~31) + perm32(R & 31);
        voffA[i] = (unsigned)(R * g.lda + C) * 2u; voffB[i] = (unsigned)(Rb * g.ldb + C) * 2u; }
    const size_t kstep = (size_t)(BK * 2);
    const size_t hstepA = (size_t)HALF * g.lda * 2, hstepB = (size_t)HALF * g.ldb * 2;
    const unsigned ldsw = (unsigned)wid * 1024u;
    const int aoff = lds_byte(wr * 64 + fr, fq * 8), boff = lds_byte(wc * 32 + fr, fq * 8);
#define PG8_SA(b, h) (((b) * 2 + (h)) * HTB)
#define PG8_SB(b, h) ((4 + (b) * 2 + (h)) * HTB)
#define PG8_STAGE(bufoff, gbase, voff) do { _Pragma("unroll") for (int _i = 0; _i < 2; ++_i) \
        glds16s((const void*)(gbase), (voff)[_i], (unsigned)(size_t)(lds + (bufoff) + ldsw + _i * 8192)); } while (0)
#define PG8_LDA(dst, b, h) do { _Pragma("unroll") for (int m = 0; m < 4; ++m) _Pragma("unroll") for (int k = 0; k < 2; ++k) dst[m][k] = *(const LAS bf16x8*)(lds + PG8_SA(b, h) + aoff + m * 2048 + k * 1024); } while (0)
#define PG8_LDB(dst, b, h) do { _Pragma("unroll") for (int n = 0; n < 2; ++n) _Pragma("unroll") for (int k = 0; k < 2; ++k) dst[n][k] = *(const LAS bf16x8*)(lds + PG8_SB(b, h) + boff + n * 2048 + k * 1024); } while (0)
#define PG8_MMA(ai, bj, At, Bt) do { __builtin_amdgcn_s_setprio(1); _Pragma("unroll") for (int m = 0; m < 4; ++m) _Pragma("unroll") for (int n = 0; n < 2; ++n) _Pragma("unroll") for (int k = 0; k < 2; ++k) \
        acc[ai][bj][m][n] = __builtin_amdgcn_mfma_f32_16x16x32_bf16(Bt[n][k], At[m][k], acc[ai][bj][m][n], 0, 0, 0); __builtin_amdgcn_s_setprio(0); } while (0)
#define PG8_WAIT_V(n) asm volatile("s_waitcnt vmcnt(" #n ")" ::: "memory")
#define PG8_WAIT_L(n) asm volatile("s_waitcnt lgkmcnt(" #n ")" ::: "memory")
#define PG8_BAR __builtin_amdgcn_s_barrier()
#define PG8_SCHED __builtin_amdgcn_sched_barrier(0)
    Unit cur, nxt; int ui = 0;
    if (!S.next(0, cur)) return;
    f32x4 acc[2][2][4][2];
#pragma unroll
    for (int a = 0; a < 2; ++a)
#pragma unroll
        for (int b = 0; b < 2; ++b)
#pragma unroll
            for (int m = 0; m < 4; ++m)
#pragma unroll
                for (int n = 0; n < 2; ++n) acc[a][b][m][n] = (f32x4){0.f, 0.f, 0.f, 0.f};
    bf16x8 At[4][2], B0[2][2], B1[2][2];
    const char* cA = (const char*)g.A + cur.offA; const char* cB = (const char*)g.Bt + cur.offB;
    PG8_STAGE(PG8_SB(0, 0), cB, voffB); PG8_STAGE(PG8_SB(0, 1), cB + hstepB, voffB); PG8_STAGE(PG8_SA(0, 0), cA, voffA); PG8_STAGE(PG8_SA(0, 1), cA + hstepA, voffA);
    if (wr == 1) PG8_BAR;
    PG8_WAIT_V(2); PG8_BAR;
    PG8_STAGE(PG8_SB(1, 0), cB + kstep, voffB); PG8_STAGE(PG8_SA(1, 0), cA + kstep, voffA); PG8_STAGE(PG8_SB(1, 1), cB + hstepB + kstep, voffB);
    PG8_WAIT_V(6); PG8_BAR;
    for (;;) {
        const bool has_next = S.next(ui + 1, nxt);
        const char* nA = has_next ? (const char*)g.A + nxt.offA : cA; const char* nB = has_next ? (const char*)g.Bt + nxt.offB : cB;
        for (int t = 0; t < nt; t += 2) {
            const bool last = (t == nt - 2);
            const char* a1 = cA + (size_t)(t + 1) * kstep;
            const char* a2 = last ? nA : cA + (size_t)(t + 2) * kstep; const char* b2 = last ? nB : cB + (size_t)(t + 2) * kstep;
            const char* a3 = a2 + kstep; const char* b3 = b2 + kstep;
            PG8_LDB(B0, 0, 0); PG8_LDB(B1, 0, 1); PG8_SCHED; PG8_LDA(At, 0, 0); PG8_STAGE(PG8_SA(1, 1), a1 + hstepA, voffA);
            PG8_WAIT_V(8); PG8_WAIT_L(0); PG8_BAR; PG8_MMA(0, 0, At, B0); PG8_MMA(0, 1, At, B1); PG8_BAR; PG8_SCHED;
            PG8_LDA(At, 0, 1); PG8_STAGE(PG8_SB(0, 0), b2, voffB); PG8_STAGE(PG8_SB(0, 1), b2 + hstepB, voffB); PG8_STAGE(PG8_SA(0, 0), a2, voffA);
            PG8_WAIT_V(8); PG8_WAIT_L(0); PG8_BAR; PG8_MMA(1, 0, At, B0); PG8_MMA(1, 1, At, B1); PG8_BAR; PG8_SCHED;
            PG8_LDB(B0, 1, 0); PG8_LDB(B1, 1, 1); PG8_SCHED; PG8_LDA(At, 1, 0); PG8_STAGE(PG8_SA(0, 1), a2 + hstepA, voffA);
            PG8_WAIT_V(8); PG8_WAIT_L(0); PG8_BAR; PG8_MMA(0, 0, At, B0); PG8_MMA(0, 1, At, B1); PG8_BAR; PG8_SCHED;
            PG8_LDA(At, 1, 1); PG8_STAGE(PG8_SB(1, 0), b3, voffB); PG8_STAGE(PG8_SB(1, 1), b3 + hstepB, voffB); PG8_STAGE(PG8_SA(1, 0), a3, voffA);
            PG8_WAIT_V(8); PG8_WAIT_L(0); PG8_BAR; PG8_MMA(1, 0, At, B0); PG8_MMA(1, 1, At, B1); PG8_BAR; PG8_SCHED;
        }
        if (!cur.chain) {
            if constexpr (ALIGN_EPI) { if (wr == 0) PG8_BAR; }
            E(acc, cur, wr, wc, fr, fq);
        }
        if (!has_next) break;
        if (!cur.chain) {
#pragma unroll
            for (int a = 0; a < 2; ++a)
#pragma unroll
                for (int b = 0; b < 2; ++b)
#pragma unroll
                    for (int m = 0; m < 4; ++m)
#pragma unroll
                        for (int n = 0; n < 2; ++n) acc[a][b][m][n] = (f32x4){0.f, 0.f, 0.f, 0.f};
            if constexpr (ALIGN_EPI) { if (wr == 1) PG8_BAR; }
        }
        cur = nxt; cA = nA; cB = nB; ++ui;
    }
    PG8_WAIT_V(0);
    if constexpr (!ALIGN_EPI) { if (wr == 0) PG8_BAR; }
    PG8_BAR;
#undef PG8_SA
#undef PG8_SB
#undef PG8_STAGE
#undef PG8_LDA
#undef PG8_LDB
#undef PG8_MMA
#undef PG8_WAIT_V
#undef PG8_WAIT_L
#undef PG8_BAR
#undef PG8_SCHED
}
}
using pg8::Unit; using pg8::Gemm;

struct Args {
    const float *x, *norm1_g, *w_in, *gla_wg2, *gla_bg, *gla_norm_g, *w_proj_gla, *q_norm_g, *k_norm_g, *idx_k_norm_g, *w_proj_dsa, *b_gate, *w_out, *norm2_g, *w_ff1, *w_ff2;
    float* out; unsigned char* ws; int ph_lo, ph_hi;
};

enum { M_INPROJ = 0, M_INDEX, M_G0, M_G1, M_G2, M_MERGE, M_OUT, M_FF1, M_FF2 };
__device__ __forceinline__ void st8bf(bf16_t* p, f32x4 a, f32x4 b) { *(u32x4*)p = pack8(a, b); }
__device__ __forceinline__ float sigm(float v) { return 1.f / (1.f + __expf(-v)); }

template <int MODE> struct Epi {
    static constexpr bool PERM = true;
    const Args* ap; int batch;
    __device__ __forceinline__ void operator()(const f32x4 (&acc)[2][2][4][2], const Unit& u, int wr, int wc, int fr, int fq) const {
        asm volatile("" : "+v"(fr), "+v"(fq));
        const Args& A = *ap; unsigned char* ws = A.ws;
        if constexpr (MODE == M_INDEX) {
            const float* IW = (const float*)(ws + WS_IW);
            f32x4 w[2][2];
#pragma unroll
            for (int bj = 0; bj < 2; ++bj) { const int t = u.pn * 16 + bj * 8 + wc * 2 + (fq >> 1); const float* wp = IW + (size_t)(batch * SEQ + t) * 16 + (fq & 1) * 8;
                w[bj][0] = *(const f32x4*)wp; w[bj][1] = *(const f32x4*)(wp + 4); }
            _Float16* SC = (_Float16*)(ws + WS_SC);
#pragma unroll
            for (int ai = 0; ai < 2; ++ai)
#pragma unroll
                for (int m = 0; m < 4; ++m) { const int s = u.pm * 256 + ai * 128 + wr * 64 + m * 16 + fr;
#pragma unroll
                    for (int bj = 0; bj < 2; ++bj) { const int t = u.pn * 16 + bj * 8 + wc * 2 + (fq >> 1);
                        const f32x4 v0 = acc[ai][bj][m][0], v1 = acc[ai][bj][m][1]; float sc = 0.f;
#pragma unroll
                        for (int q = 0; q < 4; ++q) { sc += w[bj][0][q] * fmaxf(v0[q], 0.f); sc += w[bj][1][q] * fmaxf(v1[q], 0.f); }
                        sc += shx(sc, 16, fq * 16 + fr);
                        if (!(fq & 1)) SC[(size_t)t * SEQ + s] = (_Float16)sc; } }
        } else {
            f32x4 cb[2][2];
            if constexpr (MODE == M_INPROJ) { if (u.pn >= 44 && u.pn < 60) {
#pragma unroll
                for (int bj = 0; bj < 2; ++bj) { const float* bp = A.b_gate + (u.pn - 44) * 256 + bj * 128 + wc * 32 + fq * 8; cb[bj][0] = *(const f32x4*)bp; cb[bj][1] = *(const f32x4*)(bp + 4); } } }
            if constexpr (MODE == M_G0) {
#pragma unroll
                for (int bj = 0; bj < 2; ++bj) { const float* bl = (const float*)(ws + WS_BLAST) + u.aux * 256 + bj * 128 + wc * 32 + fq * 8; const f32x4 e0 = *(const f32x4*)bl, e1 = *(const f32x4*)(bl + 4);
#pragma unroll
                    for (int q = 0; q < 4; ++q) { cb[bj][0][q] = __expf(e0[q]); cb[bj][1][q] = __expf(e1[q]); } } }
#pragma unroll
            for (int ai = 0; ai < 2; ++ai) {
                u32x4 pg[4][2], pu[4][2]; f32x4 px[4][2][2];
                float rstd[4]; (void)rstd;
                if constexpr (MODE == M_FF1) {
#pragma unroll
                    for (int m = 0; m < 4; ++m) rstd[m] = rsqrtf(((const float*)(ws + WS_RSS))[u.pm * 256 + ai * 128 + wr * 64 + m * 16 + fr] * (1.f / 2048.f) + EPS);
                }
                if constexpr (MODE == M_MERGE || MODE == M_OUT || MODE == M_FF2) {
#pragma unroll
                    for (int m = 0; m < 4; ++m)
#pragma unroll
                        for (int bj = 0; bj < 2; ++bj) { const int r = u.pm * 256 + ai * 128 + wr * 64 + m * 16 + fr, col = u.pn * 256 + bj * 128 + wc * 32 + fq * 8;
                            if constexpr (MODE == M_MERGE) { pg[m][bj] = *(const u32x4*)((const bf16_t*)A.out + (size_t)r * 4096 + u.aux * 2048 + col);
                                if (u.aux) pu[m][bj] = *(const u32x4*)((const bf16_t*)(ws + WS_U) + (size_t)r * 2048 + col); }
                            else { const float* xp = (MODE == M_OUT ? A.x : A.out) + (size_t)r * 2048 + col; px[m][bj][0] = *(const f32x4*)xp; px[m][bj][1] = *(const f32x4*)(xp + 4); } }
                }
#pragma unroll
                for (int m = 0; m < 4; ++m) {
                    const int rl = ai * 128 + wr * 64 + m * 16 + fr; const int r = u.pm * 256 + rl;
                    float rowss = 0.f; (void)rowss;
#pragma unroll
                    for (int bj = 0; bj < 2; ++bj) {
                        const int cl = bj * 128 + wc * 32 + fq * 8;
                        f32x4 v0 = acc[ai][bj][m][0], v1 = acc[ai][bj][m][1];
                        if constexpr (MODE == M_INPROJ) {
                            const int pn = u.pn;
                            if (pn < 4) { st8bf((bf16_t*)(ws + WS_GQ) + (size_t)r * 1024 + pn * 256 + cl, v0 * 0.0625f, v1 * 0.0625f); }
                            else if (pn < 8) { st8bf((bf16_t*)(ws + WS_GK) + (size_t)r * 1024 + (pn - 4) * 256 + cl, v0, v1); }
                            else if (pn < 16) {
                                const int col = (pn - 8) * 256 + cl, h = col >> 9, e = col & 511, b = r >> 13, s = r & 8191, c = s >> 8, j = s & 255;
                                bf16_t* p = (bf16_t*)(ws + WS_VT) + ((size_t)(((b * 4 + h) * 32 + c) * 512 + e)) * 256 + j;
#pragma unroll
                                for (int q = 0; q < 4; ++q) { p[q * 256] = f2bf(v0[q]); p[(q + 4) * 256] = f2bf(v1[q]); }
                            }
                            else if (pn < 24) {
#pragma unroll
                                for (int q = 0; q < 4; ++q) { v0[q] = v0[q] * sigm(v0[q]); v1[q] = v1[q] * sigm(v1[q]); }
                                st8bf((bf16_t*)(ws + WS_GR) + (size_t)r * 2048 + (pn - 16) * 256 + cl, v0, v1); }
                            else if (pn < 32) { st8bf((bf16_t*)(ws + WS_DQ) + (size_t)r * 2048 + (pn - 24) * 256 + cl, v0, v1); }
                            else if (pn < 36) {
                                const int col = ((pn - 32) & 1) * 256 + cl, kvh = col >> 7, d = col & 127, b = r >> 13, s = r & 8191;
                                bf16_t* base = (bf16_t*)(ws + (pn < 34 ? WS_DK : WS_DV));
                                st8bf(base + ((size_t)((b * 4 + kvh) * 8192 + s)) * 128 + d, v0, v1); }
                            else if (pn < 44) { st8bf((bf16_t*)(ws + WS_IQ) + (size_t)r * 2048 + (pn - 36) * 256 + cl, v0, v1); }
                            else if (pn < 60) {
                                const int col = (pn - 44) * 256 + cl;
#pragma unroll
                                for (int q = 0; q < 4; ++q) { v0[q] = sigm(v0[q] + cb[bj][0][q]); v1[q] = sigm(v1[q] + cb[bj][1][q]); }
                                st8bf((bf16_t*)A.out + (size_t)r * 4096 + col, v0, v1); }
                            else {
                                if (cl < 16) { float* p = (float*)(ws + WS_GLR) + (size_t)r * 16 + cl; *(f32x4*)p = v0; *(f32x4*)(p + 4) = v1; }
                                else if (cl < 32) { float* p = (float*)(ws + WS_IW) + (size_t)r * 16 + (cl - 16); *(f32x4*)p = v0 * 0.25f; *(f32x4*)(p + 4) = v1 * 0.25f; }
                                else if (cl < 160) { st8bf((bf16_t*)(ws + WS_IK) + (size_t)r * 128 + (cl - 32), v0, v1); }
                            }
                        } else if constexpr (MODE == M_G0) {
                            v0 = v0 * cb[bj][0]; v1 = v1 * cb[bj][1];
                            st8bf((bf16_t*)(ws + WS_ST) + ((size_t)u.aux * 512 + u.pm * 256 + rl) * 256 + cl, v0, v1);
                        } else if constexpr (MODE == M_G1) {
#pragma unroll
                            for (int q = 0; q < 4; ++q) { if (cl + q > rl) v0[q] = 0.f; if (cl + 4 + q > rl) v1[q] = 0.f; }
                            st8bf((bf16_t*)(ws + WS_P) + ((size_t)u.aux * 256 + rl) * 256 + cl, v0, v1);
                        } else if constexpr (MODE == M_G2) {
                            const int uu = u.aux, c = uu & 31, h = (uu >> 5) & 3, b = uu >> 7;
                            st8bf((bf16_t*)(ws + WS_OG) + ((size_t)(b * 8192 + c * 256 + rl)) * 2048 + h * 512 + u.pn * 256 + cl, v0, v1);
                        } else if constexpr (MODE == M_MERGE) {
                            const int col = u.pn * 256 + cl;
                            const u32x4 gw = pg[m][bj];
                            bf16_t* up = (bf16_t*)(ws + WS_U) + (size_t)r * 2048 + col;
                            f32x4 g0 = {bflo(gw.x), bfhi(gw.x), bflo(gw.y), bfhi(gw.y)}, g1 = {bflo(gw.z), bfhi(gw.z), bflo(gw.w), bfhi(gw.w)};
                            v0 = v0 * g0; v1 = v1 * g1;
                            if (u.aux) { const u32x4 pw = pu[m][bj]; v0 += (f32x4){bflo(pw.x), bfhi(pw.x), bflo(pw.y), bfhi(pw.y)}; v1 += (f32x4){bflo(pw.z), bfhi(pw.z), bflo(pw.w), bfhi(pw.w)}; }
                            st8bf(up, v0, v1);
                        } else if constexpr (MODE == M_OUT) {
                            const size_t o = (size_t)r * 2048 + u.pn * 256 + cl;
                            const f32x4 y0 = px[m][bj][0] + v0, y1 = px[m][bj][1] + v1;
                            *(f32x4*)(A.out + o) = y0; *(f32x4*)(A.out + o + 4) = y1;
                            st8bf((bf16_t*)(ws + WS_H2) + o, y0, y1);
#pragma unroll
                            for (int q = 0; q < 4; ++q) rowss += y0[q] * y0[q] + y1[q] * y1[q];
                        } else if constexpr (MODE == M_FF1) {
#pragma unroll
                            for (int q = 0; q < 4; ++q) { const float a = fmaxf(v0[q], 0.f) * rstd[m], b = fmaxf(v1[q], 0.f) * rstd[m]; v0[q] = a * a; v1[q] = b * b; }
                            st8bf((bf16_t*)(ws + WS_HM) + (size_t)r * 8192 + u.pn * 256 + cl, v0, v1);
                        } else if constexpr (MODE == M_FF2) {
                            float* o = A.out + (size_t)r * 2048 + u.pn * 256 + cl;
                            *(f32x4*)o = px[m][bj][0] + v0; *(f32x4*)(o + 4) = px[m][bj][1] + v1;
                        }
                    }
                    if constexpr (MODE == M_OUT) {
                        const int ln = fq * 16 + fr;
                        rowss += shx(rowss, 16, ln); rowss += shx(rowss, 32, ln);
                        if (fq == 0) __hip_atomic_fetch_add((float*)(ws + WS_RSS) + r, rowss, __ATOMIC_RELAXED, __HIP_MEMORY_SCOPE_AGENT);
                    }
                }
            }
        }
    }
};

struct IndexOrder {
    int G, c;
    __device__ bool next(int i, Unit& u) const {
        const int L = i * G + c; if (L >= 8448) return false;
        int qb = 0; while (16 * (qb + 1) * (qb + 2) / 2 <= L) ++qb;
        const int rem = L - 16 * qb * (qb + 1) / 2; u.pm = rem >> 4; u.pn = qb * 16 + (rem & 15);
        u.offA = (long)u.pm * 256 * 128 * 2; u.offB = (long)u.pn * 256 * 128 * 2; u.chain = 0; u.aux = 0; return true;
    }
};
struct G0Order {
    int G, c;
    __device__ bool next(int i, Unit& u) const {
        const int L = i * G + c; if (L >= 512) return false;
        const int uu = L >> 1, et = L & 1; u.pm = et; u.pn = 0; u.aux = uu;
        u.offA = (long)(WS_VT) + ((long)uu * 512 + et * 256) * 256 * 2; u.offB = (long)(WS_KT) + (long)uu * 256 * 256 * 2; u.chain = 0; return true;
    }
};
struct G1Order {
    int G, c;
    __device__ bool next(int i, Unit& u) const {
        const int L = i * G + c; if (L >= 256) return false;
        const int c_ = L & 31, h = (L >> 5) & 3, b = L >> 7; u.pm = 0; u.pn = 0; u.aux = L;
        const long off = ((long)(b * 8192 + c_ * 256) * 1024 + h * 256) * 2;
        u.offA = (long)WS_QS + (long)L * 256 * 256 * 2; u.offB = (long)WS_GK + off; u.chain = 0; return true;
    }
};
struct G2Order {
    int G, c;
    __device__ bool next(int i, Unit& u) const {
        const int L = (i >> 1) * G + c; if (L >= 512) return false;
        const int uu = L >> 1, nt_ = L & 1, part = i & 1; u.pm = 0; u.pn = nt_; u.aux = uu;
        if (part == 0) { u.offA = (long)WS_QS + (long)uu * 256 * 256 * 2; u.offB = (long)WS_ST + ((long)uu * 512 + nt_ * 256) * 256 * 2; u.chain = 1; }
        else           { u.offA = (long)WS_P  + (long)uu * 256 * 256 * 2; u.offB = (long)WS_VT + ((long)uu * 512 + nt_ * 256) * 256 * 2; u.chain = 0; }
        return true;
    }
};
struct MergeOrder {
    pg8::StaticOrder so;
    __device__ bool next(int i, Unit& u) const {
        if (!so.next(i >> 1, u)) return false;
        const int which = i & 1; u.aux = which;
        u.offA = (long)(which ? WS_DQ : WS_OG) + (long)u.pm * 256 * 2048 * 2; u.offB = (long)(which ? WS_WPD : WS_WPG) + (long)u.pn * 256 * 2048 * 2; return true;
    }
};

__device__ __forceinline__ int in_dst_row(int n) {
    if (n < 6144) return n;
    if (n < 6160) return 15360 + (n - 6144);
    if (n < 8208) return 6144 + (n - 6160);
    if (n < 8720) return 8192 + (n - 8208);
    if (n < 9232) return 8704 + (n - 8720);
    if (n < 11280) return 9216 + (n - 9232);
    if (n < 11408) return 15360 + 32 + (n - 11280);
    if (n < 11424) return 15360 + 16 + (n - 11408);
    return 11264 + (n - 11424);
}
template <bool MAP> __device__ __forceinline__ void transpose_item(const float* W, int K, int N, bf16_t* WT, LAS float* scr, int item, int lane, const float* rs = nullptr) {
    const int nblk = N / 32, kb = item / nblk, nb = item % nblk, k0 = 64 * kb, n0 = 32 * nb;
    float tv[32];
#pragma unroll
    for (int i = 0; i < 32; ++i) { const int kk = 2 * i + (lane >> 5); tv[i] = W[(size_t)(k0 + kk) * N + n0 + (lane & 31)]; }
#pragma unroll
    for (int i = 0; i < 32; ++i) { const int kk = 2 * i + (lane >> 5); scr[kk * 33 + (lane & 31)] = rs ? tv[i] * rs[k0 + kk] : tv[i]; }
    asm volatile("s_waitcnt lgkmcnt(0)" ::: "memory");
    const int c = lane & 7;
#pragma unroll
    for (int j = 0; j < 4; ++j) { const int n = (lane >> 3) + 8 * j; const LAS float* s = scr + (8 * c) * 33 + n;
        u32x4 o; o.x = cvt_pk_bf16(s[0 * 33], s[1 * 33]); o.y = cvt_pk_bf16(s[2 * 33], s[3 * 33]); o.z = cvt_pk_bf16(s[4 * 33], s[5 * 33]); o.w = cvt_pk_bf16(s[6 * 33], s[7 * 33]);
        const int dr = MAP ? in_dst_row(n0 + n) : (n0 + n);
        *(u32x4*)(WT + (size_t)dr * K + k0 + 8 * c) = o; }
    asm volatile("s_waitcnt lgkmcnt(0)" ::: "memory");
}
__device__ __forceinline__ void rms_row2_bf16(const float* xrow, const float* g, bf16_t* orow, int lane) {
    constexpr int NR = 4;
    f32x4 v[NR][8]; float s[NR];
#pragma unroll
    for (int r = 0; r < NR; ++r)
#pragma unroll
        for (int j = 0; j < 8; ++j) v[r][j] = *((const f32x4*)(xrow + (size_t)r * 2048) + 64 * j + lane);
    float rstd[NR];
#pragma unroll
    for (int r = 0; r < NR; ++r) { s[r] = 0.f;
#pragma unroll
        for (int j = 0; j < 8; ++j) s[r] += (v[r][j][0] * v[r][j][0] + v[r][j][1] * v[r][j][1]) + (v[r][j][2] * v[r][j][2] + v[r][j][3] * v[r][j][3]);
        rstd[r] = rsqrtf(wave_sum(s[r], lane) * (1.f / 2048.f) + EPS); }
#pragma unroll
    for (int j = 0; j < 8; ++j) { const f32x4 gg = *((const f32x4*)g + 64 * j + lane);
#pragma unroll
        for (int r = 0; r < NR; ++r) { const f32x4 y = v[r][j] * rstd[r] * gg; u32x2 o; o.x = cvt_pk_bf16(y[0], y[1]); o.y = cvt_pk_bf16(y[2], y[3]); *((u32x2*)(orow + (size_t)r * 2048) + 64 * j + lane) = o; } }
}

template <bool NORM, int ROT> __device__ __forceinline__ void rope_chunk(bf16_t* p, const u32x4 w, const f32x4 (&tb)[4], const float* g, float sc, int lane) {
    const int j = lane & 15;
    float x[8] = {bflo(w.x), bfhi(w.x), bflo(w.y), bfhi(w.y), bflo(w.z), bfhi(w.z), bflo(w.w), bfhi(w.w)};
    if (NORM) {
        float ss = 0.f;
#pragma unroll
        for (int q = 0; q < 8; ++q) ss += x[q] * x[q];
        ss = row16_sum(ss);
        const float rstd = rsqrtf(ss * (1.f / 128.f) + EPS);
        const f32x4 g0 = *(const f32x4*)(g + j * 8), g1 = *(const f32x4*)(g + j * 8 + 4);
#pragma unroll
        for (int q = 0; q < 4; ++q) { x[q] *= rstd * g0[q]; x[4 + q] *= rstd * g1[q]; }
    }
    constexpr int HALFL = ROT / 16;
    const bool rot = (ROT == 128) || (j < 8); const bool first = (j & HALFL) == 0;
    float o[8];
#pragma unroll
    for (int q = 0; q < 8; ++q) {
        const float other = (ROT == 128) ? DPPF(x[q], 0x128)   : shx(x[q], HALFL, lane);
        const float cs = tb[q >> 1][(q & 1) * 2], sn = tb[q >> 1][(q & 1) * 2 + 1];
        const float r = first ? (x[q] * cs - other * sn) : (x[q] * cs + other * sn);
        o[q] = (rot ? r : x[q]) * sc;
    }
    u32x4 ow; ow.x = cvt_pk_bf16(o[0], o[1]); ow.y = cvt_pk_bf16(o[2], o[3]); ow.z = cvt_pk_bf16(o[4], o[5]); ow.w = cvt_pk_bf16(o[6], o[7]);
    *(u32x4*)(p + lane * 8) = ow;
}
template <bool NORM, int ROT, bool PERTOK> __device__ __forceinline__ void rope_pass(bf16_t* base, int nchunks, const float* g, const float* tab, float sc, int gw, int NGW, int lane) {
    constexpr int NB = 8, HALFL = ROT / 16; const int j = lane & 15;
    for (int it0 = gw * NB; it0 < nchunks; it0 += NGW * NB) {
        u32x4 w[NB]; f32x4 tb[NB][4];
#pragma unroll
        for (int k = 0; k < NB; ++k) { const int it = it0 + k;
            w[k] = *(const u32x4*)(base + (size_t)it * 512 + lane * 8);
            const int pos = PERTOK ? ((it >> 2) & 8191) : (((it * 4) & 8191) + (lane >> 4));
            const float* tp = tab + (size_t)pos * ROT + (j & (HALFL - 1)) * 16;
#pragma unroll
            for (int q = 0; q < 4; ++q) tb[k][q] = *(const f32x4*)(tp + q * 4); }
#pragma unroll
        for (int k = 0; k < NB; ++k) rope_chunk<NORM, ROT>(base + (size_t)(it0 + k) * 512, w[k], tb[k], g, sc, lane);
    }
}
__device__ __forceinline__ void post_proj(const Args& A, int gw, int NGW, int lane) {
    unsigned char* ws = A.ws;
    const float* R1 = (const float*)(ws + WS_ROPE1); const float* R2 = (const float*)(ws + WS_ROPE2);
    const float qs = 0.08838834764831845f;
    rope_pass<true, 128, true>((bf16_t*)(ws + WS_DQ), T * 4, A.q_norm_g, R1, qs * 1.4426950408889634f  , gw, NGW, lane);
    rope_pass<true, 128, false>((bf16_t*)(ws + WS_DK), T, A.k_norm_g, R1, 1.f, gw, NGW, lane);
    rope_pass<false, 64, true>((bf16_t*)(ws + WS_IQ), T * 4, nullptr, R2, qs, gw, NGW, lane);
    rope_pass<true, 64, false>((bf16_t*)(ws + WS_IK), T / 4, A.idx_k_norm_g, R2, 1.f, gw, NGW, lane);
}

typedef float f32x16 __attribute__((ext_vector_type(16)));
__device__ __forceinline__ void idx_stream(unsigned char* ws, LAS unsigned char* lds, int bb, int bid, int G, int wave, int lane, int tid) {
    const bf16_t* IQ = (const bf16_t*)(ws + WS_IQ) + (size_t)bb * SEQ * 2048;
    const bf16_t* IK = (const bf16_t*)(ws + WS_IK) + (size_t)bb * SEQ * 128;
    const float* IW = (const float*)(ws + WS_IW) + (size_t)bb * SEQ * 16;
    _Float16* SC = (_Float16*)(ws + WS_SC);
    constexpr int NT = 8320, PITCH = 272, TK = 128;
    const int g0 = (int)(((long)bid * NT) / G), g1 = (int)(((long)(bid + 1) * NT) / G);
    if (g0 >= g1) return;
    int u = 0, pu = 0;
    while (pu + ((u + 4) >> 2) <= g0) { pu += (u + 4) >> 2; ++u; }
    const int rho = lane & 31, hi = lane >> 5, ha = rho >> 3, hb = (rho >> 2) & 1, hc = rho & 3;
    const int srow = tid >> 2, sseg = tid & 3;
    bf16x8 af[2][8]; float w[2][16];
    u32x4 st0, st1, st2, st3;
#define IDX_LOADA() do { _Pragma("unroll") for (int rt = 0; rt < 2; ++rt) { const int q = 32 * u + 4 * wave + 2 * rt; \
        const bf16_t* ap = IQ + (size_t)(q + hb) * 2048 + (4 * ha + hc) * 128 + 8 * hi; \
        _Pragma("unroll") for (int ks = 0; ks < 8; ++ks) af[rt][ks] = *(const bf16x8*)(ap + 16 * ks); \
        const f32x4* wp = (const f32x4*)(IW + (size_t)(q + hi) * 16); \
        _Pragma("unroll") for (int k4 = 0; k4 < 4; ++k4) { const f32x4 t4 = wp[k4]; w[rt][4 * k4] = t4[0]; w[rt][4 * k4 + 1] = t4[1]; w[rt][4 * k4 + 2] = t4[2]; w[rt][4 * k4 + 3] = t4[3]; } } } while (0)
#define IDX_LOADK(kt) do { const bf16_t* kp = IK + (size_t)((kt) * TK + srow) * 128 + sseg * 32; st0 = *(const u32x4*)kp; st1 = *(const u32x4*)(kp + 8); st2 = *(const u32x4*)(kp + 16); st3 = *(const u32x4*)(kp + 24); } while (0)
#define IDX_WRITEK(buf) do { LAS unsigned char* d = lds + (buf) * (TK * PITCH) + srow * PITCH + sseg * 64; *(LAS u32x4*)d = st0; *(LAS u32x4*)(d + 16) = st1; *(LAS u32x4*)(d + 32) = st2; *(LAS u32x4*)(d + 48) = st3; } while (0)
    IDX_LOADA();
    IDX_LOADK(g0 - pu); IDX_WRITEK(0);
    __syncthreads();
    for (int g = g0; g < g1; ++g) {
        const int kt = g - pu, buf = (g - g0) & 1;
        int un = u, pun = pu; if (g + 1 - pu >= ((u + 4) >> 2)) { pun = pu + ((u + 4) >> 2); un = u + 1; }
        if (g + 1 < g1) IDX_LOADK(g + 1 - pun);
        const LAS unsigned char* kb = lds + buf * (TK * PITCH) + rho * PITCH + hi * 16;
#pragma unroll
        for (int ct = 0; ct < TK / 32; ++ct) {
            bf16x8 bfr[8];
#pragma unroll
            for (int ks = 0; ks < 8; ++ks) bfr[ks] = *(const LAS bf16x8*)(kb + ct * 32 * PITCH + ks * 32);
            f32x16 c0, c1;
#pragma unroll
            for (int r = 0; r < 16; ++r) { c0[r] = 0.f; c1[r] = 0.f; }
#pragma unroll
            for (int ks = 0; ks < 8; ++ks) { c0 = __builtin_amdgcn_mfma_f32_32x32x16_bf16(af[0][ks], bfr[ks], c0, 0, 0, 0); c1 = __builtin_amdgcn_mfma_f32_32x32x16_bf16(af[1][ks], bfr[ks], c1, 0, 0, 0); }
            float s0 = 0.f, s1 = 0.f;
#pragma unroll
            for (int r = 0; r < 16; ++r) { s0 += w[0][r] * fmaxf(c0[r], 0.f); s1 += w[1][r] * fmaxf(c1[r], 0.f); }
            const int key = kt * TK + ct * 32 + rho, q = 32 * u + 4 * wave + hi;
            SC[(size_t)q * SEQ + key] = (_Float16)s0; SC[(size_t)(q + 2) * SEQ + key] = (_Float16)s1;
        }
        if (g + 1 < g1) IDX_WRITEK(buf ^ 1);
        if (un != u && g + 1 < g1) { u = un; pu = pun; IDX_LOADA(); }
        __syncthreads();
    }
#undef IDX_LOADA
#undef IDX_LOADK
#undef IDX_WRITEK
}

__device__ __forceinline__ void select_one(const unsigned short* sc, int t, unsigned short* idx, int lane, LAS unsigned short* li, LAS unsigned* hist) {
    if (t < 256) {
#pragma unroll
        for (int j = 0; j < 4; ++j) { const int i = j * 64 + lane; idx[i] = (unsigned short)(i <= t ? i : 0); }
        return;
    }
    unsigned key[128];
    const int ngrp = (t >> 9) + 1;
    u32x4 wv[16];
#pragma unroll
    for (int gI = 0; gI < 16; ++gI) wv[gI] = *(const u32x4*)(sc + gI * 512 + lane * 8);
#pragma unroll
    for (int gI = 0; gI < 16; ++gI) {
        const int s0 = gI * 512 + lane * 8; const u32x4 w = wv[gI];
#pragma unroll
        for (int q = 0; q < 8; ++q) { const unsigned wd = w[q >> 1]; const unsigned h = (q & 1) ? (wd >> 16) : (wd & 0xffffu);
            const unsigned k = (h & 0x8000u) ? (~h & 0xffffu) : (h | 0x8000u); key[gI * 8 + q] = (s0 + q <= t) ? k : 0u; }
    }
    unsigned thr = 0u; int ngt = 0;
    {
        const unsigned hbase = (unsigned)(size_t)hist;
        int above = 0; unsigned prefix = 0u;
#pragma unroll
        for (int pass = 0; pass < 2; ++pass) {
            *(LAS u32x4*)(hist + lane * 4) = (u32x4){0u, 0u, 0u, 0u};
            asm volatile("s_waitcnt lgkmcnt(0)" ::: "memory");
#pragma unroll
            for (int gI = 0; gI < 16; ++gI) if (gI < ngrp) {
#pragma unroll
                for (int q = 0; q < 8; ++q) { const unsigned k = key[gI * 8 + q];
                    const bool in = pass == 0 ? (k != 0u) : ((k >> 8) == prefix);
                    const unsigned bin = pass == 0 ? (k >> 8) : (k & 255u);
                    if (in) asm volatile("ds_add_u32 %0, %1" :: "v"(hbase + bin * 4u), "v"(1u) : "memory"); }
            }
            asm volatile("s_waitcnt lgkmcnt(0)" ::: "memory");
            const u32x4 h = *(const LAS u32x4*)(hist + lane * 4);
            const int sl = (int)(h.x + h.y + h.z + h.w), want = 256 - above;
            int run = 0, L = 63;
            for (; L > 0; --L) { const int v = __builtin_amdgcn_readlane(sl, L); if (run + v >= want) break; run += v; }
            int bin = 4 * L;
            { const int h3 = __builtin_amdgcn_readlane((int)h.w, L), h2 = __builtin_amdgcn_readlane((int)h.z, L), h1 = __builtin_amdgcn_readlane((int)h.y, L);
              if (run + h3 >= want) bin += 3; else { run += h3; if (run + h2 >= want) bin += 2; else { run += h2; if (run + h1 >= want) bin += 1; else run += h1; } } }
            above += run;
            if (pass == 0) prefix = (unsigned)bin; else thr = (prefix << 8) | (unsigned)bin;
        }
        ngt = above;
    }
    const int need = 256 - ngt; int bgt = 0, beq = 0;
#pragma unroll
    for (int gI = 0; gI < 16; ++gI) if (gI < ngrp) {
#pragma unroll
        for (int q = 0; q < 8; ++q) {
            const unsigned k = key[gI * 8 + q];
            const unsigned long long ms = __ballot(k >= thr);
            if (ms != 0ull) {
                const int s = gI * 512 + lane * 8 + q;
                const unsigned long long mg = __ballot(k > thr), me = ms & ~mg;
                const int rg = __builtin_amdgcn_mbcnt_hi((unsigned)(mg >> 32), __builtin_amdgcn_mbcnt_lo((unsigned)mg, 0u));
                const int re = __builtin_amdgcn_mbcnt_hi((unsigned)(me >> 32), __builtin_amdgcn_mbcnt_lo((unsigned)me, 0u));
                if (k > thr) li[bgt + rg] = (unsigned short)s;
                else if (k == thr && beq + re < need) li[ngt + beq + re] = (unsigned short)s;
                bgt += __popcll(mg); beq += __popcll(me);
            }
        }
    }
    asm volatile("s_waitcnt lgkmcnt(0)" ::: "memory");
    *(u32x2*)(idx + lane * 4) = *(const LAS u32x2*)(li + lane * 4);
}

__device__ __forceinline__ void attend_one(unsigned char* ws, LAS unsigned char* lds, int wave, int bb, int t, int kvh, int lane) {
    asm volatile("" : "+v"(lane));
    const int n = lane & 15, g = lane >> 4;
    const bf16_t* Kb = (const bf16_t*)(ws + WS_DK) + (size_t)(bb * 4 + kvh) * 8192 * 128;
    const bf16_t* Vb = (const bf16_t*)(ws + WS_DV) + (size_t)(bb * 4 + kvh) * 8192 * 128;
    bf16_t* qrow = (bf16_t*)(ws + WS_DQ) + (size_t)(bb * 8192 + t) * 2048 + kvh * 512;
    const unsigned short* ix = (const unsigned short*)(ws + WS_IDX) + (size_t)(bb * 8192 + t) * 256;
    const int cnt = t < 255 ? t + 1 : 256;
    LAS unsigned* li = (LAS unsigned*)(lds + wave * 1024);
    { const u32x2 iw = *(const u32x2*)(ix + lane * 4); *(LAS u32x4*)(li + lane * 4) = (u32x4){(iw.x & 0xffffu) << 8, (iw.x >> 16) << 8, (iw.y & 0xffffu) << 8, (iw.y >> 16) << 8}; }
    bf16x8 qf[4];
#pragma unroll
    for (int kk = 0; kk < 4; ++kk) { qf[kk] = (bf16x8){0, 0, 0, 0, 0, 0, 0, 0}; if (n < 4) qf[kk] = *(const bf16x8*)(qrow + n * 128 + kk * 32 + g * 8); }
    asm volatile("s_waitcnt vmcnt(0) lgkmcnt(0)" ::: "memory");
    bf16x8 ka[2][4][4];
#define ATT_LOADK(buf, grp) do { _Pragma("unroll") for (int tl = 0; tl < 4; ++tl) { const unsigned ko = li[((grp) * 4 + tl) * 16 + n] + (unsigned)g * 16u; \
        _Pragma("unroll") for (int kk = 0; kk < 4; ++kk) ka[buf][tl][kk] = *(const bf16x8*)((const char*)Kb + (ko + kk * 64u)); } } while (0)
    ATT_LOADK(0, 0); ATT_LOADK(1, 1);
    __builtin_amdgcn_sched_barrier(0);
    f32x4 S[16];
#pragma unroll
    for (int gi = 0; gi < 4; ++gi) {
#pragma unroll
        for (int tl = 0; tl < 4; ++tl) { f32x4 a = {0.f, 0.f, 0.f, 0.f};
#pragma unroll
            for (int kk = 0; kk < 4; ++kk) a = __builtin_amdgcn_mfma_f32_16x16x32_bf16(ka[gi & 1][tl][kk], qf[kk], a, 0, 0, 0);
            S[gi * 4 + tl] = a; }
        __builtin_amdgcn_sched_barrier(0);
        if (gi + 2 < 4) { ATT_LOADK(gi & 1, gi + 2); __builtin_amdgcn_sched_barrier(0); }
    }
#undef ATT_LOADK
    u32x4 R[3][8];
#define ATT_LOADV(buf, ks) do { const u32x4 i0 = *(const LAS u32x4*)(li + (ks) * 32 + 4 * g), i1 = *(const LAS u32x4*)(li + (ks) * 32 + 16 + 4 * g); \
        const unsigned kidx[8] = {i0.x, i0.y, i0.z, i0.w, i1.x, i1.y, i1.z, i1.w}; \
        _Pragma("unroll") for (int jj = 0; jj < 8; ++jj) R[buf][jj] = *(const u32x4*)((const char*)Vb + (kidx[jj] + (unsigned)n * 16u)); } while (0)
    ATT_LOADV(0, 0); ATT_LOADV(1, 1); ATT_LOADV(2, 2);
    __builtin_amdgcn_sched_barrier(0);
    if (cnt < 256) {
#pragma unroll
        for (int kt = 0; kt < 16; ++kt)
#pragma unroll
            for (int j = 0; j < 4; ++j) if (4 * g + j >= cnt - kt * 16) S[kt][j] = -3.0e38f;
    }
    f32x4 mx4 = S[0];
#pragma unroll
    for (int kt = 1; kt < 16; ++kt) mx4 = __builtin_elementwise_max(mx4, S[kt]);
    float mx = fmaxf(fmaxf(mx4[0], mx4[1]), fmaxf(mx4[2], mx4[3]));
    mx = fmaxf(mx, shx(mx, 16, lane)); mx = fmaxf(mx, shx(mx, 32, lane));
    f32x4 sum4 = {0.f, 0.f, 0.f, 0.f};
#pragma unroll
    for (int kt = 0; kt < 16; ++kt) { f32x4 d = S[kt] - mx;
#pragma unroll
        for (int j = 0; j < 4; ++j) d[j] = __builtin_amdgcn_exp2f(d[j]);
        S[kt] = d; sum4 += d; }
    float sum = (sum4[0] + sum4[1]) + (sum4[2] + sum4[3]);
    sum += shx(sum, 16, lane); sum += shx(sum, 32, lane);
    const float inv = 1.f / sum;
    u32x4 pa[8];
#pragma unroll
    for (int ks = 0; ks < 8; ++ks) pa[ks] = pack8(S[2 * ks], S[2 * ks + 1]);
    f32x4 O[8];
#pragma unroll
    for (int dt = 0; dt < 8; ++dt) O[dt] = (f32x4){0.f, 0.f, 0.f, 0.f};
    __builtin_amdgcn_sched_barrier(0);
#pragma unroll
    for (int ks = 0; ks < 8; ++ks) {
        const bf16x8 pk = __builtin_bit_cast(bf16x8, pa[ks]);
#pragma unroll
        for (int w = 0; w < 4; ++w) {
            u32x4 lo, hi;
#pragma unroll
            for (int a = 0; a < 4; ++a) { lo[a] = __builtin_amdgcn_perm(R[ks % 3][2 * a + 1][w], R[ks % 3][2 * a][w], 0x05040100u); hi[a] = __builtin_amdgcn_perm(R[ks % 3][2 * a + 1][w], R[ks % 3][2 * a][w], 0x07060302u); }
            O[2 * w] = __builtin_amdgcn_mfma_f32_16x16x32_bf16(pk, __builtin_bit_cast(bf16x8, lo), O[2 * w], 0, 0, 0);
            O[2 * w + 1] = __builtin_amdgcn_mfma_f32_16x16x32_bf16(pk, __builtin_bit_cast(bf16x8, hi), O[2 * w + 1], 0, 0, 0);
        }
        __builtin_amdgcn_sched_barrier(0);
        if (ks + 3 < 8) { ATT_LOADV(ks % 3, ks + 3); __builtin_amdgcn_sched_barrier(0); }
    }
#undef ATT_LOADV
#pragma unroll
    for (int j = 0; j < 4; ++j) {
        const float iv = __int_as_float(__builtin_amdgcn_readlane(__float_as_int(inv), j));
        if (g == 0) { f32x4 a = {O[0][j] * iv, O[1][j] * iv, O[2][j] * iv, O[3][j] * iv}, b = {O[4][j] * iv, O[5][j] * iv, O[6][j] * iv, O[7][j] * iv};
            st8bf(qrow + j * 128 + n * 8, a, b); }
    }
}

__device__ __forceinline__ float log_a_of(const LAS float* glr, const float (&w)[16], float bgc) {
    float z = bgc;
    const f32x4 g0 = *(const LAS f32x4*)glr, g1 = *(const LAS f32x4*)(glr + 4), g2 = *(const LAS f32x4*)(glr + 8), g3 = *(const LAS f32x4*)(glr + 12);
#pragma unroll
    for (int k = 0; k < 4; ++k) z += g0[k] * w[k] + g1[k] * w[4 + k] + g2[k] * w[8 + k] + g3[k] * w[12 + k];
    return -(fmaxf(-z, 0.f) + __logf(1.f + __expf(-fabsf(z)))) * 0.0625f;
}
__device__ __forceinline__ void gla_prep(const Args& A, LAS float* sm, int uu, int tid) {
    unsigned char* ws = A.ws;
    const int ch = tid & 255, half = __builtin_amdgcn_readfirstlane(tid >> 8);
    const int c = uu & 31, h = (uu >> 5) & 3, b = uu >> 7;
    const int tok0 = b * 8192 + c * 256 + half * 128;
    float w[16];
#pragma unroll
    for (int k = 0; k < 16; ++k) w[k] = A.gla_wg2[k * 1024 + h * 256 + ch];
    const float bgc = A.gla_bg[h * 256 + ch];
    {
        const f32x4* src = (const f32x4*)((const float*)(ws + WS_GLR) + (size_t)(b * 8192 + c * 256) * 16);
        LAS f32x4* dst = (LAS f32x4*)(sm + 1024);
        dst[tid] = src[tid]; dst[tid + 512] = src[tid + 512];
    }
    __syncthreads();
    const LAS float* GLR = sm + 1024 + half * 128 * 16;
    float s = 0.f;
#pragma unroll 4
    for (int tt = 0; tt < 128; ++tt) s += log_a_of(GLR + tt * 16, w, bgc);
    sm[half * 256 + ch] = s;
    __syncthreads();
    const float tot0 = sm[ch], blast = sm[ch] + sm[256 + ch];
    __syncthreads();
    if (half == 0) ((float*)(ws + WS_BLAST))[uu * 256 + ch] = blast;
    float bcur = half ? tot0 : 0.f;
    const bf16_t* GQ = (const bf16_t*)(ws + WS_GQ); bf16_t* GK = (bf16_t*)(ws + WS_GK);
    bf16_t* QS = (bf16_t*)(ws + WS_QS) + (size_t)uu * 256 * 256; bf16_t* KT = (bf16_t*)(ws + WS_KT) + ((size_t)uu * 256 + ch) * 256 + half * 128;
    unsigned short qn[8], kn[8];
#pragma unroll
    for (int q = 0; q < 8; ++q) { const size_t o = (size_t)(tok0 + q) * 1024 + h * 256 + ch; qn[q] = GQ[o]; kn[q] = GK[o]; }
    for (int t8 = 0; t8 < 16; ++t8) {
        float kp[8], qv[8], kv[8];
#pragma unroll
        for (int q = 0; q < 8; ++q) { qv[q] = bf2f(qn[q]); kv[q] = bf2f(kn[q]); }
        if (t8 < 15) {
#pragma unroll
            for (int q = 0; q < 8; ++q) { const size_t o = (size_t)(tok0 + (t8 + 1) * 8 + q) * 1024 + h * 256 + ch; qn[q] = GQ[o]; kn[q] = GK[o]; }
        }
#pragma unroll
        for (int q = 0; q < 8; ++q) {
            const int tt = t8 * 8 + q; const size_t tok = (size_t)(tok0 + tt);
            bcur += log_a_of(GLR + tt * 16, w, bgc);
            const float eb = __expf(bcur), ieb = __expf(-bcur);
            QS[(size_t)(half * 128 + tt) * 256 + ch] = f2bf(qv[q] * eb);
            kp[q] = kv[q] * ieb;
            GK[tok * 1024 + h * 256 + ch] = f2bf(kp[q]);
        }
        u32x4 o; o.x = cvt_pk_bf16(kp[0], kp[1]); o.y = cvt_pk_bf16(kp[2], kp[3]); o.z = cvt_pk_bf16(kp[4], kp[5]); o.w = cvt_pk_bf16(kp[6], kp[7]);
        *(u32x4*)(KT + t8 * 8) = o;
    }
}
__device__ __forceinline__ void gla_scan(unsigned char* ws, int gt, int NGT) {
    const float* BL = (const float*)(ws + WS_BLAST);
    for (int it = gt; it < 8 * 512 * 32; it += NGT) {
        const int d8 = it & 31, e = (it >> 5) & 511, bh = it >> 14;
        float S[8];
#pragma unroll
        for (int q = 0; q < 8; ++q) S[q] = 0.f;
        for (int c0 = 0; c0 < 32; c0 += 4) {
            u32x4 uw[4]; f32x4 d0[4], d1[4];
#pragma unroll
            for (int k = 0; k < 4; ++k) { const int uu = bh * 32 + c0 + k;
                uw[k] = *(const u32x4*)((const bf16_t*)(ws + WS_ST) + ((size_t)uu * 512 + e) * 256 + d8 * 8);
                d0[k] = *(const f32x4*)(BL + uu * 256 + d8 * 8); d1[k] = *(const f32x4*)(BL + uu * 256 + d8 * 8 + 4); }
#pragma unroll
            for (int k = 0; k < 4; ++k) { const int uu = bh * 32 + c0 + k;
                u32x4 o; o.x = cvt_pk_bf16(S[0], S[1]); o.y = cvt_pk_bf16(S[2], S[3]); o.z = cvt_pk_bf16(S[4], S[5]); o.w = cvt_pk_bf16(S[6], S[7]);
                *(u32x4*)((bf16_t*)(ws + WS_ST) + ((size_t)uu * 512 + e) * 256 + d8 * 8) = o;
                S[0] = S[0] * __expf(d0[k][0]) + bflo(uw[k].x); S[1] = S[1] * __expf(d0[k][1]) + bfhi(uw[k].x); S[2] = S[2] * __expf(d0[k][2]) + bflo(uw[k].y); S[3] = S[3] * __expf(d0[k][3]) + bfhi(uw[k].y);
                S[4] = S[4] * __expf(d1[k][0]) + bflo(uw[k].z); S[5] = S[5] * __expf(d1[k][1]) + bfhi(uw[k].z); S[6] = S[6] * __expf(d1[k][2]) + bflo(uw[k].w); S[7] = S[7] * __expf(d1[k][3]) + bfhi(uw[k].w); }
        }
    }
}
__device__ __forceinline__ void gla_post(const Args& A, int gw, int NGW, int lane) {
    unsigned char* ws = A.ws;
    const f32x4 g0 = *(const f32x4*)(A.gla_norm_g + lane * 8), g1 = *(const f32x4*)(A.gla_norm_g + lane * 8 + 4);
    for (int it0 = gw * 4; it0 < T * 4; it0 += NGW * 4) {
        u32x4 xw[4], gw4[4];
#pragma unroll
        for (int k = 0; k < 4; ++k) { const int it = it0 + k; const size_t o = (size_t)(it >> 2) * 2048 + (it & 3) * 512 + lane * 8;
            xw[k] = *(const u32x4*)((const bf16_t*)(ws + WS_OG) + o); gw4[k] = *(const u32x4*)((const bf16_t*)(ws + WS_GR) + o); }
#pragma unroll
        for (int k = 0; k < 4; ++k) { const int it = it0 + k; const size_t o = (size_t)(it >> 2) * 2048 + (it & 3) * 512 + lane * 8;
            f32x4 x0 = {bflo(xw[k].x), bfhi(xw[k].x), bflo(xw[k].y), bfhi(xw[k].y)}, x1 = {bflo(xw[k].z), bfhi(xw[k].z), bflo(xw[k].w), bfhi(xw[k].w)};
            const f32x4 r0 = {bflo(gw4[k].x), bfhi(gw4[k].x), bflo(gw4[k].y), bfhi(gw4[k].y)}, r1 = {bflo(gw4[k].z), bfhi(gw4[k].z), bflo(gw4[k].w), bfhi(gw4[k].w)};
            float ss = 0.f;
#pragma unroll
            for (int q = 0; q < 4; ++q) ss += x0[q] * x0[q] + x1[q] * x1[q];
            const float rstd = rsqrtf(wave_sum(ss, lane) * (1.f / 512.f) + EPS);
            x0 = x0 * rstd * g0 * r0; x1 = x1 * rstd * g1 * r1;
            *(u32x4*)((bf16_t*)(ws + WS_OG) + o) = pack8(x0, x1); }
    }
}

#define XB_TMO      128
#define XB_XCNT(j)  (256  + 64 * (j))
#define XB_XSUB(j)  (1280 + 64 * (j))
#define XB_XGEN(j)  (2304 + 64 * (j))
#define XB_TOP      3328
#define XB_TOPGEN   3392
#define XCD_BAR_WORDS 3456
#define XB_SPIN_CAP (1u << 22)
#define RLX_AGENT __ATOMIC_RELAXED, __HIP_MEMORY_SCOPE_AGENT
__device__ __forceinline__ unsigned xb_ld(unsigned* p)              { return __hip_atomic_load(p, RLX_AGENT); }
__device__ __forceinline__ unsigned xb_add(unsigned* p, unsigned v) { return __hip_atomic_fetch_add(p, v, RLX_AGENT); }
__device__ __forceinline__ unsigned xb_xcc_id() { return (unsigned)__builtin_amdgcn_s_getreg((3 << 11) | 20) & 0xFu; }
#define XB_SPIN(cond, bar) do { unsigned _sp = 0; while (cond) { __builtin_amdgcn_s_sleep(1); \
    if ((++_sp & 255u) == 0u) { if (xb_ld(&(bar)[XB_TMO])) break; if (_sp > XB_SPIN_CAP) { atomicAdd(&(bar)[XB_TMO], 1u); break; } } } } while (0)
__device__ __forceinline__ void xcd_barrier_complete(unsigned* bar, unsigned x, unsigned G, unsigned& nloc, unsigned& nx) {
    unsigned sum, cnt, mine, sp = 0u;
    for (;;) {
        sum = 0u; cnt = 0u; mine = 0u;
#pragma unroll
        for (unsigned j = 0; j < 16; ++j) { const unsigned c = xb_ld(&bar[XB_XCNT(j)]); sum += c; cnt += (c > 0u) ? 1u : 0u; mine = (j == x) ? c : mine; }
        if (sum == G) break;
        __builtin_amdgcn_s_sleep(1);
        if ((++sp & 255u) == 0u) { if (xb_ld(&bar[XB_TMO])) break; if (sp > XB_SPIN_CAP) { atomicAdd(&bar[XB_TMO], 1u); break; } }
    }
    nloc = mine > 0u ? mine : 1u; nx = cnt > 0u ? cnt : 1u;
}
__device__ __forceinline__ void grid_bar(unsigned* bar, volatile LAS unsigned* st, unsigned G, int wave) {
    asm volatile("s_waitcnt vmcnt(0) lgkmcnt(0)" ::: "memory");
    __syncthreads();
    int l; asm volatile("v_mbcnt_lo_u32_b32 %0, -1, 0\n\tv_mbcnt_hi_u32_b32 %0, -1, %0" : "=v"(l));
    if (wave == 0 && l == 0) {
        const unsigned x = xb_xcc_id();
        __builtin_amdgcn_s_waitcnt(0);
        unsigned nloc = st[0], nx = st[1];
        if (nloc == 0u) { xcd_barrier_complete(bar, x, G, nloc, nx); st[0] = nloc; st[1] = nx; }
        const unsigned old = xb_add(&bar[XB_XSUB(x)], 1u);
        const unsigned gen = old / nloc;
        if (old + 1u == (gen + 1u) * nloc) {
            __builtin_amdgcn_fence(__ATOMIC_RELEASE, "agent");
            asm volatile("s_waitcnt vmcnt(0)" ::: "memory");
            const unsigned og = xb_add(&bar[XB_TOP], 1u);
            const unsigned tg = og / nx;
            if (og + 1u == (tg + 1u) * nx) xb_add(&bar[XB_TOPGEN], 1u);
            else XB_SPIN(xb_ld(&bar[XB_TOPGEN]) == tg, bar);
            __builtin_amdgcn_fence(__ATOMIC_ACQUIRE, "agent");
            xb_add(&bar[XB_XGEN(x)], 1u);
            asm volatile("s_waitcnt vmcnt(0)" ::: "memory");
        } else {
            XB_SPIN(xb_ld(&bar[XB_XGEN(x)]) == gen, bar);
            __builtin_amdgcn_fence(__ATOMIC_ACQUIRE, "agent");
            asm volatile("s_waitcnt vmcnt(0)" ::: "memory");
        }
    }
    __syncthreads();
}
__device__ __forceinline__ Args load_args() {
    Args a{};
#if defined(__HIP_DEVICE_COMPILE__)
    const __attribute__((address_space(4))) unsigned long long* q = (const __attribute__((address_space(4))) unsigned long long*)__builtin_amdgcn_kernarg_segment_ptr();
    asm volatile("" : "+s"(q));
    unsigned long long* d = (unsigned long long*)&a;
#pragma unroll
    for (int i = 0; i < (int)(sizeof(Args) / 8); ++i) d[i] = q[i];
#endif
    return a;
}
__global__ void __launch_bounds__(512, 2) hybrid_fwd(Args A0) {
    extern __shared__ __attribute__((aligned(16))) unsigned char lds_raw[];
    LAS unsigned char* lds = (LAS unsigned char*)lds_raw;
    cg::grid_group grid = cg::this_grid();
    unsigned char* ws = A0.ws; const int ph_lo = A0.ph_lo, ph_hi = A0.ph_hi;
    const int G = gridDim.x, bid = blockIdx.x;
    const int NGW = G * 8;
    const int wave = __builtin_amdgcn_readfirstlane(threadIdx.x >> 6);
    const Gemm gws{(const bf16_t*)ws, (const bf16_t*)ws, 256, 256, 256};
    int ph = 0;
    volatile LAS unsigned* bst = (volatile LAS unsigned*)(lds + 131072);
    { int l0; asm volatile("v_mbcnt_lo_u32_b32 %0, -1, 0\n\tv_mbcnt_hi_u32_b32 %0, -1, %0" : "=v"(l0));
      if (wave == 0 && l0 == 0) { const unsigned x0 = xb_xcc_id(); bst[0] = 0u; bst[1] = 0u; bst[3] = x0; bst[2] = xb_add(&((unsigned*)ws)[XB_XCNT(x0)], 1u); } }
    grid.sync();
#ifndef PHMASK
#define PHMASK 0xffffffffu
#endif
#define PHASE_BEGIN(id) if (((PHMASK >> (id)) & 1u) && ph >= ph_lo && ph < ph_hi) { const Args A = load_args(); int lane; asm volatile("v_mbcnt_lo_u32_b32 %0, -1, 0\n\tv_mbcnt_hi_u32_b32 %0, -1, %0" : "=v"(lane)); const int tid = wave * 64 + lane, gw = bid * 8 + wave; (void)tid; LAS float* scr = (LAS float*)(lds + wave * 16384); (void)lane; (void)gw; (void)scr;
#define PHASE_END_NOBAR } ++ph; __syncthreads();
#define PHASE_END } ++ph; if (ph > ph_lo && ph < ph_hi) { grid_bar((unsigned*)ws, bst, (unsigned)G, wave); }

    PHASE_BEGIN(0)
        for (int it = gw; it < 32 * (NPROJ / 32); it += NGW) transpose_item<true>(A.w_in, DM, NPROJ, (bf16_t*)(ws + WS_WTIN), scr, it, lane);
        for (int m = gw * 4; m < T; m += NGW * 4) rms_row2_bf16(A.x + (size_t)m * DM, A.norm1_g, (bf16_t*)(ws + WS_H) + (size_t)m * DM, lane);
        for (int i = bid * 512 + tid; i < T; i += G * 512) ((float*)(ws + WS_RSS))[i] = 0.f;
        for (int i = bid * 512 + tid; i < SEQ * 96; i += G * 512) {
            const int pos = i / 96, j = i % 96;
            if (j < 64) { const float f = powf(10000.f, -(float)j * 2.0f / 128.f); const float a = (float)pos * f; float sn, cs; sincosf(a, &sn, &cs);
                ((float*)(ws + WS_ROPE1))[(size_t)pos * 128 + j * 2] = cs; ((float*)(ws + WS_ROPE1))[(size_t)pos * 128 + j * 2 + 1] = sn; }
            else { const int jj = j - 64; const float f = powf(10000.f, -(float)jj * 2.0f / 64.f); const float a = (float)pos * f; float sn, cs; sincosf(a, &sn, &cs);
                ((float*)(ws + WS_ROPE2))[(size_t)pos * 64 + jj * 2] = cs; ((float*)(ws + WS_ROPE2))[(size_t)pos * 64 + jj * 2 + 1] = sn; }
        }
    PHASE_END
    PHASE_BEGIN(1)
        const Gemm g{(const bf16_t*)(ws + WS_H), (const bf16_t*)(ws + WS_WTIN), DM, DM, DM};
        pg8::StaticOrder S; S.init(T, NPROJ_PAD, DM, DM, G, bid);
        Epi<M_INPROJ> E{&A, 0};
        pg8::gemm_phase<Epi<M_INPROJ>, pg8::StaticOrder, true>(lds, g, S, E, wave);
    PHASE_END
    PHASE_BEGIN(2)
        post_proj(A, gw, NGW, lane);
    PHASE_END
#define DSA_ROUND(bb, ATT_END) \
        PHASE_BEGIN(3) \
            idx_stream(ws, lds, bb, bid, G, wave, lane, tid); \
        PHASE_END \
        PHASE_BEGIN(4) \
            for (int t = gw; t < SEQ; t += NGW) \
                select_one((const unsigned short*)(ws + WS_SC) + (size_t)t * SEQ, t, (unsigned short*)(ws + WS_IDX) + (size_t)(bb * SEQ + t) * 256, lane, (LAS unsigned short*)(lds + wave * 512), (LAS unsigned*)(lds + 4096 + wave * 1024)); \
        PHASE_END \
        PHASE_BEGIN(5) \
            const bool xl = (G == 256) && bst[0] == 32u && bst[1] == 8u && bst[3] < 8u; const int xq = (int)bst[3], kvh0 = xq & 3, qh = (xq >> 2) & 1, lw = (int)bst[2] * 8 + wave; \
            for (int it = gw, k = 0; xl ? (k < 16) : (it < SEQ * 4); it += NGW, ++k) attend_one(ws, lds, wave, bb, xl ? (lw + 256 * k) * 2 + qh : (it >> 2), xl ? kvh0 : (it & 3), lane); \
        ATT_END
    DSA_ROUND(0, PHASE_END_NOBAR)
    DSA_ROUND(1, PHASE_END)
#undef DSA_ROUND
    PHASE_BEGIN(6)
        for (int uu = bid; uu < 256; uu += G) { gla_prep(A, (LAS float*)lds, uu, tid); __syncthreads(); }
    PHASE_END
    PHASE_BEGIN(7)
        { G0Order S{G, bid}; Epi<M_G0> E{&A, 0}; pg8::gemm_phase<Epi<M_G0>, G0Order, true>(lds, gws, S, E, wave); }
        { Gemm g1 = gws; g1.lda = 256; g1.ldb = 1024; G1Order S{G, bid}; Epi<M_G1> E{&A, 0}; pg8::gemm_phase<Epi<M_G1>, G1Order, true>(lds, g1, S, E, wave); }
    PHASE_END
    PHASE_BEGIN(8)
        gla_scan(ws, bid * 512 + tid, G * 512);
    PHASE_END
    PHASE_BEGIN(9)
        G2Order S{G, bid}; Epi<M_G2> E{&A, 0}; pg8::gemm_phase<Epi<M_G2>, G2Order, true>(lds, gws, S, E, wave);
    PHASE_END
    PHASE_BEGIN(10)
        gla_post(A, gw, NGW, lane);
        constexpr int I_P = 32 * 64, I_F = 32 * 256;
        for (int it = gw; it < 3 * I_P + 2 * I_F; it += NGW) {
            int r = it;
            if (r < I_P) { transpose_item<false>(A.w_proj_gla, 2048, 2048, (bf16_t*)(ws + WS_WPG), scr, r, lane); continue; } r -= I_P;
            if (r < I_P) { transpose_item<false>(A.w_proj_dsa, 2048, 2048, (bf16_t*)(ws + WS_WPD), scr, r, lane); continue; } r -= I_P;
            if (r < I_P) { transpose_item<false>(A.w_out, 2048, 2048, (bf16_t*)(ws + WS_WO), scr, r, lane); continue; } r -= I_P;
            if (r < I_F) { transpose_item<false>(A.w_ff1, 2048, 8192, (bf16_t*)(ws + WS_WF1), scr, r, lane, A.norm2_g); continue; }     r -= I_F;
            transpose_item<false>(A.w_ff2, 8192, 2048, (bf16_t*)(ws + WS_WF2), scr, r, lane);
        }
    PHASE_END
    PHASE_BEGIN(11)
        Gemm g = gws; g.lda = 2048; g.ldb = 2048; g.K = 2048;
        MergeOrder S; S.so.init(T, DM, DM, DM, G, bid); Epi<M_MERGE> E{&A, 0};
        pg8::gemm_phase<Epi<M_MERGE>, MergeOrder, true>(lds, g, S, E, wave);
    PHASE_END
    PHASE_BEGIN(12)
        const Gemm g{(const bf16_t*)(ws + WS_U), (const bf16_t*)(ws + WS_WO), DM, DM, DM};
        pg8::StaticOrder S; S.init(T, DM, DM, DM, G, bid); Epi<M_OUT> E{&A, 0};
        pg8::gemm_phase<Epi<M_OUT>, pg8::StaticOrder, true>(lds, g, S, E, wave);
    PHASE_END
    PHASE_BEGIN(14)
        const Gemm g{(const bf16_t*)(ws + WS_H2), (const bf16_t*)(ws + WS_WF1), DM, DM, DM};
        pg8::StaticOrder S; S.init(T, DFF, DM, DM, G, bid); Epi<M_FF1> E{&A, 0};
        pg8::gemm_phase<Epi<M_FF1>, pg8::StaticOrder, true>(lds, g, S, E, wave);
    PHASE_END
    PHASE_BEGIN(15)
        const Gemm g{(const bf16_t*)(ws + WS_HM), (const bf16_t*)(ws + WS_WF2), DFF, DFF, DFF};
        pg8::StaticOrder S; S.init(T, DM, DFF, DFF, G, bid); Epi<M_FF2> E{&A, 0};
        pg8::gemm_phase<Epi<M_FF2>, pg8::StaticOrder, true>(lds, g, S, E, wave);
    PHASE_END
}

constexpr int LDS_BYTES = 131072 + 4096;
extern "C" void kernel_launch(void* const* d_in, const int* in_sizes, int n_in, void* d_out, int out_size, void* d_ws, size_t ws_size, hipStream_t stream) {
    static int grid = 0;
    if (grid == 0) {
        if (n_in != 16 || ws_size < WS_NEED) { fprintf(stderr, "kernel_launch: need 16 inputs and >= %zu bytes of workspace (got %d, %zu)\n", (size_t)WS_NEED, n_in, ws_size); grid = -1; return; }
        int dev = 0, cus = 0, per_cu = 0;
        hipGetDevice(&dev); hipDeviceGetAttribute(&cus, hipDeviceAttributeMultiprocessorCount, dev);
        if (hipFuncSetAttribute((const void*)hybrid_fwd, hipFuncAttributeMaxDynamicSharedMemorySize, LDS_BYTES) != hipSuccess) { fprintf(stderr, "kernel_launch: hipFuncSetAttribute failed\n"); grid = -1; return; }
        if (hipOccupancyMaxActiveBlocksPerMultiprocessor(&per_cu, (const void*)hybrid_fwd, 512, LDS_BYTES) != hipSuccess || per_cu < 1) { fprintf(stderr, "kernel_launch: occupancy query gave %d\n", per_cu); per_cu = 1; }
        (void)hipGetLastError();
        grid = cus * 1;
    }
    if (grid < 0) return;
    Args a{};
    const float** f = (const float**)&a;
    for (int i = 0; i < 16; ++i) f[i] = (const float*)d_in[i];
    a.out = (float*)d_out; a.ws = (unsigned char*)d_ws; a.ph_lo = 0; a.ph_hi = 1000;
    if (hipMemsetAsync(d_ws, 0, 16384, stream) != hipSuccess) { fprintf(stderr, "kernel_launch: memset failed\n"); return; }
    void* args[] = {&a};
    hipError_t e = hipLaunchCooperativeKernel((const void*)hybrid_fwd, dim3(grid), dim3(512), args, LDS_BYTES, stream);
    if (e != hipSuccess) fprintf(stderr, "cooperative launch failed: %s (grid %d)\n", hipGetErrorString(e), grid);
}
```

```cpp
#include <hip/hip_runtime.h>
#include <hip/hip_cooperative_groups.h>
#include <cstdio>
#include <cstdint>
namespace cg = cooperative_groups;

#define LAS __attribute__((address_space(3)))
typedef unsigned short bf16_t;
typedef short bf16x8 __attribute__((ext_vector_type(8)));
typedef float f32x4 __attribute__((ext_vector_type(4)));
typedef unsigned u32x4 __attribute__((ext_vector_type(4)));
typedef unsigned u32x2 __attribute__((ext_vector_type(2)));

constexpr int T = 16384, SEQ = 8192, DM = 2048, DFF = 8192, NPROJ = 15520, NPROJ_PAD = 15616;
constexpr float EPS = 1e-6f;
constexpr size_t MiB = 1u << 20;
constexpr size_t WS_GLR = 1 * MiB, WS_IW = 2 * MiB, WS_BLAST = 3 * MiB, WS_ROPE1 = 4 * MiB, WS_ROPE2 = 8 * MiB, WS_IK = 10 * MiB, WS_IDX = 14 * MiB, WS_CNT = 22 * MiB;
constexpr size_t WS_GQ = 24 * MiB, WS_GK = 56 * MiB, WS_VT = 88 * MiB, WS_GR = 152 * MiB, WS_DQ = 216 * MiB, WS_DK = 280 * MiB, WS_DV = 296 * MiB, WS_IQ = 312 * MiB;
constexpr size_t WS_WTIN = 376 * MiB, WS_H = 437 * MiB;
constexpr size_t WS_SC = 376 * MiB;
constexpr size_t WS_QS = 280 * MiB, WS_P = 312 * MiB, WS_ST = 344 * MiB, WS_KT = 408 * MiB, WS_OG = 440 * MiB;
constexpr size_t WS_WPG = 24 * MiB, WS_WPD = 32 * MiB, WS_WO = 40 * MiB, WS_WF1 = 48 * MiB, WS_WF2 = 80 * MiB;
constexpr size_t WS_U = 280 * MiB, WS_H2 = 440 * MiB, WS_HM = 112 * MiB;
constexpr size_t WS_RSS = 22 * MiB;
constexpr size_t WS_NEED = 512 * MiB;

__device__ __forceinline__ unsigned cvt_pk_bf16(float lo, float hi) { unsigned r; asm volatile("v_cvt_pk_bf16_f32 %0, %1, %2" : "=v"(r) : "v"(lo), "v"(hi)); return r; }
__device__ __forceinline__ float bf2f(unsigned short b) { return __uint_as_float(((unsigned)b) << 16); }
__device__ __forceinline__ float bflo(unsigned w) { return __uint_as_float(w << 16); }
__device__ __forceinline__ float bfhi(unsigned w) { return __uint_as_float(w & 0xffff0000u); }
__device__ __forceinline__ unsigned short f2bf(float f) { return (unsigned short)(cvt_pk_bf16(f, 0.f) & 0xffffu); }
__device__ __forceinline__ float shx(float v, int m, int lane) { return __int_as_float(__builtin_amdgcn_ds_bpermute((lane ^ m) << 2, __float_as_int(v))); }
#define DPPF(v, ctrl) __int_as_float(__builtin_amdgcn_update_dpp(0, __float_as_int(v), (ctrl), 0xf, 0xf, false))
__device__ __forceinline__ float row16_sum(float x) { x += DPPF(x, 0xB1); x += DPPF(x, 0x4E); x += DPPF(x, 0x141); x += DPPF(x, 0x140); return x; }
__device__ __forceinline__ float wave_sum(float v, int lane) {
    (void)lane; const float x = row16_sum(v);
    return (__int_as_float(__builtin_amdgcn_readlane(__float_as_int(x), 0)) + __int_as_float(__builtin_amdgcn_readlane(__float_as_int(x), 16)))
         + (__int_as_float(__builtin_amdgcn_readlane(__float_as_int(x), 32)) + __int_as_float(__builtin_amdgcn_readlane(__float_as_int(x), 48)));
}
__device__ __forceinline__ u32x4 pack8(f32x4 a, f32x4 b) { u32x4 w; w.x = cvt_pk_bf16(a[0], a[1]); w.y = cvt_pk_bf16(a[2], a[3]); w.z = cvt_pk_bf16(b[0], b[1]); w.w = cvt_pk_bf16(b[2], b[3]); return w; }

namespace pg8 {
constexpr int BM = 256, BK = 64, HALF = 128, HTB = HALF * BK * 2, STAGE_BYTES = 8 * HTB, NXCD = 8, WGM = 8;
__host__ __device__ __forceinline__ int lds_byte(int r, int c) { const int st = (r >> 4) * 2 + (c >> 5), rr = r & 15, cc = c & 31, ob = rr * 64 + cc * 2; return st * 1024 + (ob ^ (((ob >> 9) & 1) << 5)); }
__host__ __device__ __forceinline__ void stage_rc(int b, int& R, int& C) { const int st = b / 1024, sb = b % 1024, swz = sb ^ (((sb >> 9) & 1) << 5); R = (st >> 1) * 16 + swz / 64; C = (st & 1) * 32 + (swz % 64) / 2; }
__host__ __device__ __forceinline__ int perm32(int rho) { const int n = rho >> 4, i = rho & 15; return 8 * (i >> 2) + 4 * n + (i & 3); }

__device__ __forceinline__ void glds16s(const void* sbase, unsigned voff, unsigned lds_dst) { unsigned keep;
    asm volatile("s_mov_b32 %0, m0\n\ts_mov_b32 m0, %3\n\ts_nop 0\n\tglobal_load_lds_dwordx4 %1, %2\n\ts_mov_b32 m0, %0" : "=&s"(keep) : "v"(voff), "s"(sbase), "s"(lds_dst) : "memory"); }
struct Unit { int pm, pn; long offA, offB; int chain, aux; };
struct Gemm { const bf16_t* A; const bf16_t* Bt; int lda, ldb, K; };

struct StaticOrder {
    int nM, nN, nwg, G, c, wgm; long sA, sB;
    __device__ void init(int M, int N, int lda, int ldb, int G_, int c_, int wgm_ = WGM) { nM = M / BM; nN = N / BM; nwg = nM * nN; G = G_; c = c_; wgm = wgm_; sA = (long)BM * lda * 2; sB = (long)BM * ldb * 2; }
    __device__ bool next(int i, Unit& u) const {
        const long L = (long)i * G + c; if (L >= nwg) return false;
        int wgid = (int)L; { const int q = nwg / NXCD, r = nwg % NXCD, xcd = wgid % NXCD, off = wgid / NXCD; wgid = (xcd < r ? xcd * (q + 1) : r * (q + 1) + (xcd - r) * q) + off; }
        const int nig = wgm * nN, gid = wgid / nig, fm = gid * wgm, gsz = (nM - fm) < wgm ? (nM - fm) : wgm;
        u.pm = fm + ((wgid % nig) % gsz); u.pn = (wgid % nig) / gsz; u.offA = u.pm * sA; u.offB = u.pn * sB; u.chain = 0; u.aux = 0; return true;
    }
};

template <class Epi, class Sched, bool ALIGN_EPI>
__device__ __forceinline__ void gemm_phase(LAS unsigned char* lds, const Gemm g, const Sched& S, const Epi& E, int wid) {
    int lane; asm volatile("v_mbcnt_lo_u32_b32 %0, -1, 0\n\tv_mbcnt_hi_u32_b32 %0, -1, %0" : "=v"(lane));
    const int tid = wid * 64 + lane; const int wr = wid >> 2, wc = wid & 3, fr = lane & 15, fq = lane >> 4;
    const int K = g.K, nt = K / BK;
    unsigned voffA[2], voffB[2];
#pragma unroll
    for (int i = 0; i < 2; ++i) { int R, C; stage_rc(tid * 16 + i * 8192, R, C); const int Rb = (R & ~31) + perm32(R & 31);
        voffA[i] = (unsigned)(R * g.lda + C) * 2u; voffB[i] = (unsigned)(Rb * g.ldb + C) * 2u; }
    const size_t kstep = (size_t)(BK * 2);
    const size_t hstepA = (size_t)HALF * g.lda * 2, hstepB = (size_t)HALF * g.ldb * 2;
    const unsigned ldsw = (unsigned)wid * 1024u;
    const int aoff = lds_byte(wr * 64 + fr, fq * 8), boff = lds_byte(wc * 32 + fr, fq * 8);
#define PG8_SA(b, h) (((b) * 2 + (h)) * HTB)
#define PG8_SB(b, h) ((4 + (b) * 2 + (h)) * HTB)
#define PG8_STAGE(bufoff, gbase, voff) do { _Pragma("unroll") for (int _i = 0; _i < 2; ++_i) \
        glds16s((const void*)(gbase), (voff)[_i], (unsigned)(size_t)(lds + (bufoff) + ldsw + _i * 8192)); } while (0)
#define PG8_LDA(dst, b, h) do { _Pragma("unroll") for (int m = 0; m < 4; ++m) _Pragma("unroll") for (int k = 0; k < 2; ++k) dst[m][k] = *(const LAS bf16x8*)(lds + PG8_SA(b, h) + aoff + m * 2048 + k * 1024); } while (0)
#define PG8_LDB(dst, b, h) do { _Pragma("unroll") for (int n = 0; n < 2; ++n) _Pragma("unroll") for (int k = 0; k < 2; ++k) dst[n][k] = *(const LAS bf16x8*)(lds + PG8_SB(b, h) + boff + n * 2048 + k * 1024); } while (0)
#define PG8_MMA(ai, bj, At, Bt) do { __builtin_amdgcn_s_setprio(1); _Pragma("unroll") for (int m = 0; m < 4; ++m) _Pragma("unroll") for (int n = 0; n < 2; ++n) _Pragma("unroll") for (int k = 0; k < 2; ++k) \
        acc[ai][bj][m][n] = __builtin_amdgcn_mfma_f32_16x16x32_bf16(Bt[n][k], At[m][k], acc[ai][bj][m][n], 0, 0, 0); __builtin_amdgcn_s_setprio(0); } while (0)
#define PG8_WAIT_V(n) asm volatile("s_waitcnt vmcnt(" #n ")" ::: "memory")
#define PG8_WAIT_L(n) asm volatile("s_waitcnt lgkmcnt(" #n ")" ::: "memory")
#define PG8_BAR __builtin_amdgcn_s_barrier()
#define PG8_SCHED __builtin_amdgcn_sched_barrier(0)
    Unit cur, nxt; int ui = 0;
    if (!S.next(0, cur)) return;
    f32x4 acc[2][2][4][2];
#pragma unroll
    for (int a = 0; a < 2; ++a)
#pragma unroll
        for (int b = 0; b < 2; ++b)
#pragma unroll
            for (int m = 0; m < 4; ++m)
#pragma unroll
                for (int n = 0; n < 2; ++n) acc[a][b][m][n] = (f32x4){0.f, 0.f, 0.f, 0.f};
    bf16x8 At[4][2], B0[2][2], B1[2][2];
    const char* cA = (const char*)g.A + cur.offA; const char* cB = (const char*)g.Bt + cur.offB;
    PG8_STAGE(PG8_SB(0, 0), cB, voffB); PG8_STAGE(PG8_SB(0, 1), cB + hstepB, voffB); PG8_STAGE(PG8_SA(0, 0), cA, voffA); PG8_STAGE(PG8_SA(0, 1), cA + hstepA, voffA);
    if (wr == 1) PG8_BAR;
    PG8_WAIT_V(2); PG8_BAR;
    PG8_STAGE(PG8_SB(1, 0), cB + kstep, voffB); PG8_STAGE(PG8_SA(1, 0), cA + kstep, voffA); PG8_STAGE(PG8_SB(1, 1), cB + hstepB + kstep, voffB);
    PG8_WAIT_V(6); PG8_BAR;
    for (;;) {
        const bool has_next = S.next(ui + 1, nxt);
        const char* nA = has_next ? (const char*)g.A + nxt.offA : cA; const char* nB = has_next ? (const char*)g.Bt + nxt.offB : cB;
        for (int t = 0; t < nt; t += 2) {
            const bool last = (t == nt - 2);
            const char* a1 = cA + (size_t)(t + 1) * kstep;
            const char* a2 = last ? nA : cA + (size_t)(t + 2) * kstep; const char* b2 = last ? nB : cB + (size_t)(t + 2) * kstep;
            const char* a3 = a2 + kstep; const char* b3 = b2 + kstep;
            PG8_LDB(B0, 0, 0); PG8_LDB(B1, 0, 1); PG8_SCHED; PG8_LDA(At, 0, 0); PG8_STAGE(PG8_SA(1, 1), a1 + hstepA, voffA);
            PG8_WAIT_V(8); PG8_WAIT_L(0); PG8_BAR; PG8_MMA(0, 0, At, B0); PG8_MMA(0, 1, At, B1); PG8_BAR; PG8_SCHED;
            PG8_LDA(At, 0, 1); PG8_STAGE(PG8_SB(0, 0), b2, voffB); PG8_STAGE(PG8_SB(0, 1), b2 + hstepB, voffB); PG8_STAGE(PG8_SA(0, 0), a2, voffA);
            PG8_WAIT_V(8); PG8_WAIT_L(0); PG8_BAR; PG8_MMA(1, 0, At, B0); PG8_MMA(1, 1, At, B1); PG8_BAR; PG8_SCHED;
            PG8_LDB(B0, 1, 0); PG8_LDB(B1, 1, 1); PG8_SCHED; PG8_LDA(At, 1, 0); PG8_STAGE(PG8_SA(0, 1), a2 + hstepA, voffA);
            PG8_WAIT_V(8); PG8_WAIT_L(0); PG8_BAR; PG8_MMA(0, 0, At, B0); PG8_MMA(0, 1, At, B1); PG8_BAR; PG8_SCHED;
            PG8_LDA(At, 1, 1); PG8_STAGE(PG8_SB(1, 0), b3, voffB); PG8_STAGE(PG8_SB(1, 1), b3 + hstepB, voffB); PG8_STAGE(PG8_SA(1, 0), a3, voffA);
            PG8_WAIT_V(8); PG8_WAIT_L(0); PG8_BAR; PG8_MMA(1, 0, At, B0); PG8_MMA(1, 1, At, B1); PG8_BAR; PG8_SCHED;
        }
        if (!cur.chain) {
            if constexpr (ALIGN_EPI) { if (wr == 0) PG8_BAR; }
            E(acc, cur, wr, wc, fr, fq);
        }
        if (!has_next) break;
        if (!cur.chain) {
#pragma unroll
            for (int a = 0; a < 2; ++a)
#pragma unroll
                for (int b = 0; b < 2; ++b)
#pragma unroll
                    for (int m = 0; m < 4; ++m)
#pragma unroll
                        for (int n = 0; n < 2; ++n) acc[a][b][m][n] = (f32x4){0.f, 0.f, 0.f, 0.f};
            if constexpr (ALIGN_EPI) { if (wr == 1) PG8_BAR; }
        }
        cur = nxt; cA = nA; cB = nB; ++ui;
    }
    PG8_WAIT_V(0);
    if constexpr (!ALIGN_EPI) { if (wr == 0) PG8_BAR; }
    PG8_BAR;
#undef PG8_SA
#undef PG8_SB
#undef PG8_STAGE
#undef PG8_LDA
#undef PG8_LDB
#undef PG8_MMA
#undef PG8_WAIT_V
#undef PG8_WAIT_L
#undef PG8_BAR
#undef PG8_SCHED
}
}
using pg8::Unit; using pg8::Gemm;

struct Args {
    const float *x, *norm1_g, *w_in, *gla_wg2, *gla_bg, *gla_norm_g, *w_proj_gla, *q_norm_g, *k_norm_g, *idx_k_norm_g, *w_proj_dsa, *b_gate, *w_out, *norm2_g, *w_ff1, *w_ff2;
    float* out; unsigned char* ws; int ph_lo, ph_hi;
};

enum { M_INPROJ = 0, M_INDEX, M_G0, M_G1, M_G2, M_MERGE, M_OUT, M_FF1, M_FF2 };
__device__ __forceinline__ void st8bf(bf16_t* p, f32x4 a, f32x4 b) { *(u32x4*)p = pack8(a, b); }
__device__ __forceinline__ float sigm(float v) { return 1.f / (1.f + __expf(-v)); }

template <int MODE> struct Epi {
    static constexpr bool PERM = true;
    const Args* ap; int batch;
    __device__ __forceinline__ void operator()(const f32x4 (&acc)[2][2][4][2], const Unit& u, int wr, int wc, int fr, int fq) const {
        asm volatile("" : "+v"(fr), "+v"(fq));
        const Args& A = *ap; unsigned char* ws = A.ws;
        if constexpr (MODE == M_INDEX) {
            const float* IW = (const float*)(ws + WS_IW);
            f32x4 w[2][2];
#pragma unroll
            for (int bj = 0; bj < 2; ++bj) { const int t = u.pn * 16 + bj * 8 + wc * 2 + (fq >> 1); const float* wp = IW + (size_t)(batch * SEQ + t) * 16 + (fq & 1) * 8;
                w[bj][0] = *(const f32x4*)wp; w[bj][1] = *(const f32x4*)(wp + 4); }
            _Float16* SC = (_Float16*)(ws + WS_SC);
#pragma unroll
            for (int ai = 0; ai < 2; ++ai)
#pragma unroll
                for (int m = 0; m < 4; ++m) { const int s = u.pm * 256 + ai * 128 + wr * 64 + m * 16 + fr;
#pragma unroll
                    for (int bj = 0; bj < 2; ++bj) { const int t = u.pn * 16 + bj * 8 + wc * 2 + (fq >> 1);
                        const f32x4 v0 = acc[ai][bj][m][0], v1 = acc[ai][bj][m][1]; float sc = 0.f;
#pragma unroll
                        for (int q = 0; q < 4; ++q) { sc += w[bj][0][q] * fmaxf(v0[q], 0.f); sc += w[bj][1][q] * fmaxf(v1[q], 0.f); }
                        sc += shx(sc, 16, fq * 16 + fr);
                        if (!(fq & 1)) SC[(size_t)t * SEQ + s] = (_Float16)sc; } }
        } else {
            f32x4 cb[2][2];
            if constexpr (MODE == M_INPROJ) { if (u.pn >= 44 && u.pn < 60) {
#pragma unroll
                for (int bj = 0; bj < 2; ++bj) { const float* bp = A.b_gate + (u.pn - 44) * 256 + bj * 128 + wc * 32 + fq * 8; cb[bj][0] = *(const f32x4*)bp; cb[bj][1] = *(const f32x4*)(bp + 4); } } }
            if constexpr (MODE == M_G0) {
#pragma unroll
                for (int bj = 0; bj < 2; ++bj) { const float* bl = (const float*)(ws + WS_BLAST) + u.aux * 256 + bj * 128 + wc * 32 + fq * 8; const f32x4 e0 = *(const f32x4*)bl, e1 = *(const f32x4*)(bl + 4);
#pragma unroll
                    for (int q = 0; q < 4; ++q) { cb[bj][0][q] = __expf(e0[q]); cb[bj][1][q] = __expf(e1[q]); } } }
#pragma unroll
            for (int ai = 0; ai < 2; ++ai) {
                u32x4 pg[4][2], pu[4][2]; f32x4 px[4][2][2];
                float rstd[4]; (void)rstd;
                if constexpr (MODE == M_FF1) {
#pragma unroll
                    for (int m = 0; m < 4; ++m) rstd[m] = rsqrtf(((const float*)(ws + WS_RSS))[u.pm * 256 + ai * 128 + wr * 64 + m * 16 + fr] * (1.f / 2048.f) + EPS);
                }
                if constexpr (MODE == M_MERGE || MODE == M_OUT || MODE == M_FF2) {
#pragma unroll
                    for (int m = 0; m < 4; ++m)
#pragma unroll
                        for (int bj = 0; bj < 2; ++bj) { const int r = u.pm * 256 + ai * 128 + wr * 64 + m * 16 + fr, col = u.pn * 256 + bj * 128 + wc * 32 + fq * 8;
                            if constexpr (MODE == M_MERGE) { pg[m][bj] = *(const u32x4*)((const bf16_t*)A.out + (size_t)r * 4096 + u.aux * 2048 + col);
                                if (u.aux) pu[m][bj] = *(const u32x4*)((const bf16_t*)(ws + WS_U) + (size_t)r * 2048 + col); }
                            else { const float* xp = (MODE == M_OUT ? A.x : A.out) + (size_t)r * 2048 + col; px[m][bj][0] = *(const f32x4*)xp; px[m][bj][1] = *(const f32x4*)(xp + 4); } }
                }
#pragma unroll
                for (int m = 0; m < 4; ++m) {
                    const int rl = ai * 128 + wr * 64 + m * 16 + fr; const int r = u.pm * 256 + rl;
                    float rowss = 0.f; (void)rowss;
#pragma unroll
                    for (int bj = 0; bj < 2; ++bj) {
                        const int cl = bj * 128 + wc * 32 + fq * 8;
                        f32x4 v0 = acc[ai][bj][m][0], v1 = acc[ai][bj][m][1];
                        if constexpr (MODE == M_INPROJ) {
                            const int pn = u.pn;
                            if (pn < 4) { st8bf((bf16_t*)(ws + WS_GQ) + (size_t)r * 1024 + pn * 256 + cl, v0 * 0.0625f, v1 * 0.0625f); }
                            else if (pn < 8) { st8bf((bf16_t*)(ws + WS_GK) + (size_t)r * 1024 + (pn - 4) * 256 + cl, v0, v1); }
                            else if (pn < 16) {
                                const int col = (pn - 8) * 256 + cl, h = col >> 9, e = col & 511, b = r >> 13, s = r & 8191, c = s >> 8, j = s & 255;
                                bf16_t* p = (bf16_t*)(ws + WS_VT) + ((size_t)(((b * 4 + h) * 32 + c) * 512 + e)) * 256 + j;
#pragma unroll
                                for (int q = 0; q < 4; ++q) { p[q * 256] = f2bf(v0[q]); p[(q + 4) * 256] = f2bf(v1[q]); }
                            }
                            else if (pn < 24) {
#pragma unroll
                                for (int q = 0; q < 4; ++q) { v0[q] = v0[q] * sigm(v0[q]); v1[q] = v1[q] * sigm(v1[q]); }
                                st8bf((bf16_t*)(ws + WS_GR) + (size_t)r * 2048 + (pn - 16) * 256 + cl, v0, v1); }
                            else if (pn < 32) { st8bf((bf16_t*)(ws + WS_DQ) + (size_t)r * 2048 + (pn - 24) * 256 + cl, v0, v1); }
                            else if (pn < 36) {
                                const int col = ((pn - 32) & 1) * 256 + cl, kvh = col >> 7, d = col & 127, b = r >> 13, s = r & 8191;
                                bf16_t* base = (bf16_t*)(ws + (pn < 34 ? WS_DK : WS_DV));
                                st8bf(base + ((size_t)((b * 4 + kvh) * 8192 + s)) * 128 + d, v0, v1); }
                            else if (pn < 44) { st8bf((bf16_t*)(ws + WS_IQ) + (size_t)r * 2048 + (pn - 36) * 256 + cl, v0, v1); }
                            else if (pn < 60) {
                                const int col = (pn - 44) * 256 + cl;
#pragma unroll
                                for (int q = 0; q < 4; ++q) { v0[q] = sigm(v0[q] + cb[bj][0][q]); v1[q] = sigm(v1[q] + cb[bj][1][q]); }
                                st8bf((bf16_t*)A.out + (size_t)r * 4096 + col, v0, v1); }
                            else {
                                if (cl < 16) { float* p = (float*)(ws + WS_GLR) + (size_t)r * 16 + cl; *(f32x4*)p = v0; *(f32x4*)(p + 4) = v1; }
                                else if (cl < 32) { float* p = (float*)(ws + WS_IW) + (size_t)r * 16 + (cl - 16); *(f32x4*)p = v0 * 0.25f; *(f32x4*)(p + 4) = v1 * 0.25f; }
                                else if (cl < 160) { st8bf((bf16_t*)(ws + WS_IK) + (size_t)r * 128 + (cl - 32), v0, v1); }
                            }
                        } else if constexpr (MODE == M_G0) {
                            v0 = v0 * cb[bj][0]; v1 = v1 * cb[bj][1];
                            st8bf((bf16_t*)(ws + WS_ST) + ((size_t)u.aux * 512 + u.pm * 256 + rl) * 256 + cl, v0, v1);
                        } else if constexpr (MODE == M_G1) {
#pragma unroll
                            for (int q = 0; q < 4; ++q) { if (cl + q > rl) v0[q] = 0.f; if (cl + 4 + q > rl) v1[q] = 0.f; }
                            st8bf((bf16_t*)(ws + WS_P) + ((size_t)u.aux * 256 + rl) * 256 + cl, v0, v1);
                        } else if constexpr (MODE == M_G2) {
                            const int uu = u.aux, c = uu & 31, h = (uu >> 5) & 3, b = uu >> 7;
                            st8bf((bf16_t*)(ws + WS_OG) + ((size_t)(b * 8192 + c * 256 + rl)) * 2048 + h * 512 + u.pn * 256 + cl, v0, v1);
                        } else if constexpr (MODE == M_MERGE) {
                            const int col = u.pn * 256 + cl;
                            const u32x4 gw = pg[m][bj];
                            bf16_t* up = (bf16_t*)(ws + WS_U) + (size_t)r * 2048 + col;
                            f32x4 g0 = {bflo(gw.x), bfhi(gw.x), bflo(gw.y), bfhi(gw.y)}, g1 = {bflo(gw.z), bfhi(gw.z), bflo(gw.w), bfhi(gw.w)};
                            v0 = v0 * g0; v1 = v1 * g1;
                            if (u.aux) { const u32x4 pw = pu[m][bj]; v0 += (f32x4){bflo(pw.x), bfhi(pw.x), bflo(pw.y), bfhi(pw.y)}; v1 += (f32x4){bflo(pw.z), bfhi(pw.z), bflo(pw.w), bfhi(pw.w)}; }
                            st8bf(up, v0, v1);
                        } else if constexpr (MODE == M_OUT) {
                            const size_t o = (size_t)r * 2048 + u.pn * 256 + cl;
                            const f32x4 y0 = px[m][bj][0] + v0, y1 = px[m][bj][1] + v1;
                            *(f32x4*)(A.out + o) = y0; *(f32x4*)(A.out + o + 4) = y1;
                            st8bf((bf16_t*)(ws + WS_H2) + o, y0, y1);
#pragma unroll
                            for (int q = 0; q < 4; ++q) rowss += y0[q] * y0[q] + y1[q] * y1[q];
                        } else if constexpr (MODE == M_FF1) {
#pragma unroll
                            for (int q = 0; q < 4; ++q) { const float a = fmaxf(v0[q], 0.f) * rstd[m], b = fmaxf(v1[q], 0.f) * rstd[m]; v0[q] = a * a; v1[q] = b * b; }
                            st8bf((bf16_t*)(ws + WS_HM) + (size_t)r * 8192 + u.pn * 256 + cl, v0, v1);
                        } else if constexpr (MODE == M_FF2) {
                            float* o = A.out + (size_t)r * 2048 + u.pn * 256 + cl;
                            *(f32x4*)o = px[m][bj][0] + v0; *(f32x4*)(o + 4) = px[m][bj][1] + v1;
                        }
                    }
                    if constexpr (MODE == M_OUT) {
                        const int ln = fq * 16 + fr;
                        rowss += shx(rowss, 16, ln); rowss += shx(rowss, 32, ln);
                        if (fq == 0) __hip_atomic_fetch_add((float*)(ws + WS_RSS) + r, rowss, __ATOMIC_RELAXED, __HIP_MEMORY_SCOPE_AGENT);
                    }
                }
            }
        }
    }
};

struct IndexOrder {
    int G, c;
    __device__ bool next(int i, Unit& u) const {
        const int L = i * G + c; if (L >= 8448) return false;
        int qb = 0; while (16 * (qb + 1) * (qb + 2) / 2 <= L) ++qb;
        const int rem = L - 16 * qb * (qb + 1) / 2; u.pm = rem >> 4; u.pn = qb * 16 + (rem & 15);
        u.offA = (long)u.pm * 256 * 128 * 2; u.offB = (long)u.pn * 256 * 128 * 2; u.chain = 0; u.aux = 0; return true;
    }
};
struct G0Order {
    int G, c;
    __device__ bool next(int i, Unit& u) const {
        const int L = i * G + c; if (L >= 512) return false;
        const int uu = L >> 1, et = L & 1; u.pm = et; u.pn = 0; u.aux = uu;
        u.offA = (long)(WS_VT) + ((long)uu * 512 + et * 256) * 256 * 2; u.offB = (long)(WS_KT) + (long)uu * 256 * 256 * 2; u.chain = 0; return true;
    }
};
struct G1Order {
    int G, c;
    __device__ bool next(int i, Unit& u) const {
        const int L = i * G + c; if (L >= 256) return false;
        const int c_ = L & 31, h = (L >> 5) & 3, b = L >> 7; u.pm = 0; u.pn = 0; u.aux = L;
        const long off = ((long)(b * 8192 + c_ * 256) * 1024 + h * 256) * 2;
        u.offA = (long)WS_QS + (long)L * 256 * 256 * 2; u.offB = (long)WS_GK + off; u.chain = 0; return true;
    }
};
struct G2Order {
    int G, c;
    __device__ bool next(int i, Unit& u) const {
        const int L = (i >> 1) * G + c; if (L >= 512) return false;
        const int uu = L >> 1, nt_ = L & 1, part = i & 1; u.pm = 0; u.pn = nt_; u.aux = uu;
        if (part == 0) { u.offA = (long)WS_QS + (long)uu * 256 * 256 * 2; u.offB = (long)WS_ST + ((long)uu * 512 + nt_ * 256) * 256 * 2; u.chain = 1; }
        else           { u.offA = (long)WS_P  + (long)uu * 256 * 256 * 2; u.offB = (long)WS_VT + ((long)uu * 512 + nt_ * 256) * 256 * 2; u.chain = 0; }
        return true;
    }
};
struct MergeOrder {
    pg8::StaticOrder so;
    __device__ bool next(int i, Unit& u) const {
        if (!so.next(i >> 1, u)) return false;
        const int which = i & 1; u.aux = which;
        u.offA = (long)(which ? WS_DQ : WS_OG) + (long)u.pm * 256 * 2048 * 2; u.offB = (long)(which ? WS_WPD : WS_WPG) + (long)u.pn * 256 * 2048 * 2; return true;
    }
};

__device__ __forceinline__ int in_dst_row(int n) {
    if (n < 6144) return n;
    if (n < 6160) return 15360 + (n - 6144);
    if (n < 8208) return 6144 + (n - 6160);
    if (n < 8720) return 8192 + (n - 8208);
    if (n < 9232) return 8704 + (n - 8720);
    if (n < 11280) return 9216 + (n - 9232);
    if (n < 11408) return 15360 + 32 + (n - 11280);
    if (n < 11424) return 15360 + 16 + (n - 11408);
    return 11264 + (n - 11424);
}
template <bool MAP> __device__ __forceinline__ void transpose_item(const float* W, int K, int N, bf16_t* WT, LAS float* scr, int item, int lane, const float* rs = nullptr) {
    const int nblk = N / 32, kb = item / nblk, nb = item % nblk, k0 = 64 * kb, n0 = 32 * nb;
    float tv[32];
#pragma unroll
    for (int i = 0; i < 32; ++i) { const int kk = 2 * i + (lane >> 5); tv[i] = W[(size_t)(k0 + kk) * N + n0 + (lane & 31)]; }
#pragma unroll
    for (int i = 0; i < 32; ++i) { const int kk = 2 * i + (lane >> 5); scr[kk * 33 + (lane & 31)] = rs ? tv[i] * rs[k0 + kk] : tv[i]; }
    asm volatile("s_waitcnt lgkmcnt(0)" ::: "memory");
    const int c = lane & 7;
#pragma unroll
    for (int j = 0; j < 4; ++j) { const int n = (lane >> 3) + 8 * j; const LAS float* s = scr + (8 * c) * 33 + n;
        u32x4 o; o.x = cvt_pk_bf16(s[0 * 33], s[1 * 33]); o.y = cvt_pk_bf16(s[2 * 33], s[3 * 33]); o.z = cvt_pk_bf16(s[4 * 33], s[5 * 33]); o.w = cvt_pk_bf16(s[6 * 33], s[7 * 33]);
        const int dr = MAP ? in_dst_row(n0 + n) : (n0 + n);
        *(u32x4*)(WT + (size_t)dr * K + k0 + 8 * c) = o; }
    asm volatile("s_waitcnt lgkmcnt(0)" ::: "memory");
}
__device__ __forceinline__ void rms_row2_bf16(const float* xrow, const float* g, bf16_t* orow, int lane) {
    constexpr int NR = 4;
    f32x4 v[NR][8]; float s[NR];
#pragma unroll
    for (int r = 0; r < NR; ++r)
#pragma unroll
        for (int j = 0; j < 8; ++j) v[r][j] = *((const f32x4*)(xrow + (size_t)r * 2048) + 64 * j + lane);
    float rstd[NR];
#pragma unroll
    for (int r = 0; r < NR; ++r) { s[r] = 0.f;
#pragma unroll
        for (int j = 0; j < 8; ++j) s[r] += (v[r][j][0] * v[r][j][0] + v[r][j][1] * v[r][j][1]) + (v[r][j][2] * v[r][j][2] + v[r][j][3] * v[r][j][3]);
        rstd[r] = rsqrtf(wave_sum(s[r], lane) * (1.f / 2048.f) + EPS); }
#pragma unroll
    for (int j = 0; j < 8; ++j) { const f32x4 gg = *((const f32x4*)g + 64 * j + lane);
#pragma unroll
        for (int r = 0; r < NR; ++r) { const f32x4 y = v[r][j] * rstd[r] * gg; u32x2 o; o.x = cvt_pk_bf16(y[0], y[1]); o.y = cvt_pk_bf16(y[2], y[3]); *((u32x2*)(orow + (size_t)r * 2048) + 64 * j + lane) = o; } }
}

template <bool NORM, int ROT> __device__ __forceinline__ void rope_chunk(bf16_t* p, const u32x4 w, const f32x4 (&tb)[4], const float* g, float sc, int lane) {
    const int j = lane & 15;
    float x[8] = {bflo(w.x), bfhi(w.x), bflo(w.y), bfhi(w.y), bflo(w.z), bfhi(w.z), bflo(w.w), bfhi(w.w)};
    if (NORM) {
        float ss = 0.f;
#pragma unroll
        for (int q = 0; q < 8; ++q) ss += x[q] * x[q];
        ss = row16_sum(ss);
        const float rstd = rsqrtf(ss * (1.f / 128.f) + EPS);
        const f32x4 g0 = *(const f32x4*)(g + j * 8), g1 = *(const f32x4*)(g + j * 8 + 4);
#pragma unroll
        for (int q = 0; q < 4; ++q) { x[q] *= rstd * g0[q]; x[4 + q] *= rstd * g1[q]; }
    }
    constexpr int HALFL = ROT / 16;
    const bool rot = (ROT == 128) || (j < 8); const bool first = (j & HALFL) == 0;
    float o[8];
#pragma unroll
    for (int q = 0; q < 8; ++q) {
        const float other = (ROT == 128) ? DPPF(x[q], 0x128)   : shx(x[q], HALFL, lane);
        const float cs = tb[q >> 1][(q & 1) * 2], sn = tb[q >> 1][(q & 1) * 2 + 1];
        const float r = first ? (x[q] * cs - other * sn) : (x[q] * cs + other * sn);
        o[q] = (rot ? r : x[q]) * sc;
    }
    u32x4 ow; ow.x = cvt_pk_bf16(o[0], o[1]); ow.y = cvt_pk_bf16(o[2], o[3]); ow.z = cvt_pk_bf16(o[4], o[5]); ow.w = cvt_pk_bf16(o[6], o[7]);
    *(u32x4*)(p + lane * 8) = ow;
}
template <bool NORM, int ROT, bool PERTOK> __device__ __forceinline__ void rope_pass(bf16_t* base, int nchunks, const float* g, const float* tab, float sc, int gw, int NGW, int lane) {
    constexpr int NB = 8, HALFL = ROT / 16; const int j = lane & 15;
    for (int it0 = gw * NB; it0 < nchunks; it0 += NGW * NB) {
        u32x4 w[NB]; f32x4 tb[NB][4];
#pragma unroll
        for (int k = 0; k < NB; ++k) { const int it = it0 + k;
            w[k] = *(const u32x4*)(base + (size_t)it * 512 + lane * 8);
            const int pos = PERTOK ? ((it >> 2) & 8191) : (((it * 4) & 8191) + (lane >> 4));
            const float* tp = tab + (size_t)pos * ROT + (j & (HALFL - 1)) * 16;
#pragma unroll
            for (int q = 0; q < 4; ++q) tb[k][q] = *(const f32x4*)(tp + q * 4); }
#pragma unroll
        for (int k = 0; k < NB; ++k) rope_chunk<NORM, ROT>(base + (size_t)(it0 + k) * 512, w[k], tb[k], g, sc, lane);
    }
}
__device__ __forceinline__ void post_proj(const Args& A, int gw, int NGW, int lane) {
    unsigned char* ws = A.ws;
    const float* R1 = (const float*)(ws + WS_ROPE1); const float* R2 = (const float*)(ws + WS_ROPE2);
    const float qs = 0.08838834764831845f;
    rope_pass<true, 128, true>((bf16_t*)(ws + WS_DQ), T * 4, A.q_norm_g, R1, qs * 1.4426950408889634f  , gw, NGW, lane);
    rope_pass<true, 128, false>((bf16_t*)(ws + WS_DK), T, A.k_norm_g, R1, 1.f, gw, NGW, lane);
    rope_pass<false, 64, true>((bf16_t*)(ws + WS_IQ), T * 4, nullptr, R2, qs, gw, NGW, lane);
    rope_pass<true, 64, false>((bf16_t*)(ws + WS_IK), T / 4, A.idx_k_norm_g, R2, 1.f, gw, NGW, lane);
}

typedef float f32x16 __attribute__((ext_vector_type(16)));
__device__ __forceinline__ void idx_stream(unsigned char* ws, LAS unsigned char* lds, int bb, int bid, int G, int wave, int lane, int tid) {
    const bf16_t* IQ = (const bf16_t*)(ws + WS_IQ) + (size_t)bb * SEQ * 2048;
    const bf16_t* IK = (const bf16_t*)(ws + WS_IK) + (size_t)bb * SEQ * 128;
    const float* IW = (const float*)(ws + WS_IW) + (size_t)bb * SEQ * 16;
    _Float16* SC = (_Float16*)(ws + WS_SC);
    constexpr int NT = 8320, PITCH = 272, TK = 128;
    const int g0 = (int)(((long)bid * NT) / G), g1 = (int)(((long)(bid + 1) * NT) / G);
    if (g0 >= g1) return;
    int u = 0, pu = 0;
    while (pu + ((u + 4) >> 2) <= g0) { pu += (u + 4) >> 2; ++u; }
    const int rho = lane & 31, hi = lane >> 5, ha = rho >> 3, hb = (rho >> 2) & 1, hc = rho & 3;
    const int srow = tid >> 2, sseg = tid & 3;
    bf16x8 af[2][8]; float w[2][16];
    u32x4 st0, st1, st2, st3;
#define IDX_LOADA() do { _Pragma("unroll") for (int rt = 0; rt < 2; ++rt) { const int q = 32 * u + 4 * wave + 2 * rt; \
        const bf16_t* ap = IQ + (size_t)(q + hb) * 2048 + (4 * ha + hc) * 128 + 8 * hi; \
        _Pragma("unroll") for (int ks = 0; ks < 8; ++ks) af[rt][ks] = *(const bf16x8*)(ap + 16 * ks); \
        const f32x4* wp = (const f32x4*)(IW + (size_t)(q + hi) * 16); \
        _Pragma("unroll") for (int k4 = 0; k4 < 4; ++k4) { const f32x4 t4 = wp[k4]; w[rt][4 * k4] = t4[0]; w[rt][4 * k4 + 1] = t4[1]; w[rt][4 * k4 + 2] = t4[2]; w[rt][4 * k4 + 3] = t4[3]; } } } while (0)
#define IDX_LOADK(kt) do { const bf16_t* kp = IK + (size_t)((kt) * TK + srow) * 128 + sseg * 32; st0 = *(const u32x4*)kp; st1 = *(const u32x4*)(kp + 8); st2 = *(const u32x4*)(kp + 16); st3 = *(const u32x4*)(kp + 24); } while (0)
#define IDX_WRITEK(buf) do { LAS unsigned char* d = lds + (buf) * (TK * PITCH) + srow * PITCH + sseg * 64; *(LAS u32x4*)d = st0; *(LAS u32x4*)(d + 16) = st1; *(LAS u32x4*)(d + 32) = st2; *(LAS u32x4*)(d + 48) = st3; } while (0)
    IDX_LOADA();
    IDX_LOADK(g0 - pu); IDX_WRITEK(0);
    __syncthreads();
    for (int g = g0; g < g1; ++g) {
        const int kt = g - pu, buf = (g - g0) & 1;
        int un = u, pun = pu; if (g + 1 - pu >= ((u + 4) >> 2)) { pun = pu + ((u + 4) >> 2); un = u + 1; }
        if (g + 1 < g1) IDX_LOADK(g + 1 - pun);
        const LAS unsigned char* kb = lds + buf * (TK * PITCH) + rho * PITCH + hi * 16;
#pragma unroll
        for (int ct = 0; ct < TK / 32; ++ct) {
            bf16x8 bfr[8];
#pragma unroll
            for (int ks = 0; ks < 8; ++ks) bfr[ks] = *(const LAS bf16x8*)(kb + ct * 32 * PITCH + ks * 32);
            f32x16 c0, c1;
#pragma unroll
            for (int r = 0; r < 16; ++r) { c0[r] = 0.f; c1[r] = 0.f; }
#pragma unroll
            for (int ks = 0; ks < 8; ++ks) { c0 = __builtin_amdgcn_mfma_f32_32x32x16_bf16(af[0][ks], bfr[ks], c0, 0, 0, 0); c1 = __builtin_amdgcn_mfma_f32_32x32x16_bf16(af[1][ks], bfr[ks], c1, 0, 0, 0); }
            float s0 = 0.f, s1 = 0.f;
#pragma unroll
            for (int r = 0; r < 16; ++r) { s0 += w[0][r] * fmaxf(c0[r], 0.f); s1 += w[1][r] * fmaxf(c1[r], 0.f); }
            const int key = kt * TK + ct * 32 + rho, q = 32 * u + 4 * wave + hi;
            SC[(size_t)q * SEQ + key] = (_Float16)s0; SC[(size_t)(q + 2) * SEQ + key] = (_Float16)s1;
        }
        if (g + 1 < g1) IDX_WRITEK(buf ^ 1);
        if (un != u && g + 1 < g1) { u = un; pu = pun; IDX_LOADA(); }
        __syncthreads();
    }
#undef IDX_LOADA
#undef IDX_LOADK
#undef IDX_WRITEK
}

__device__ __forceinline__ void select_one(const unsigned short* sc, int t, unsigned short* idx, int lane, LAS unsigned short* li, LAS unsigned* hist) {
    if (t < 256) {
#pragma unroll
        for (int j = 0; j < 4; ++j) { const int i = j * 64 + lane; idx[i] = (unsigned short)(i <= t ? i : 0); }
        return;
    }
    unsigned key[128];
    const int ngrp = (t >> 9) + 1;
    u32x4 wv[16];
#pragma unroll
    for (int gI = 0; gI < 16; ++gI) wv[gI] = *(const u32x4*)(sc + gI * 512 + lane * 8);
#pragma unroll
    for (int gI = 0; gI < 16; ++gI) {
        const int s0 = gI * 512 + lane * 8; const u32x4 w = wv[gI];
#pragma unroll
        for (int q = 0; q < 8; ++q) { const unsigned wd = w[q >> 1]; const unsigned h = (q & 1) ? (wd >> 16) : (wd & 0xffffu);
            const unsigned k = (h & 0x8000u) ? (~h & 0xffffu) : (h | 0x8000u); key[gI * 8 + q] = (s0 + q <= t) ? k : 0u; }
    }
    unsigned thr = 0u; int ngt = 0;
    {
        const unsigned hbase = (unsigned)(size_t)hist;
        int above = 0; unsigned prefix = 0u;
#pragma unroll
        for (int pass = 0; pass < 2; ++pass) {
            *(LAS u32x4*)(hist + lane * 4) = (u32x4){0u, 0u, 0u, 0u};
            asm volatile("s_waitcnt lgkmcnt(0)" ::: "memory");
#pragma unroll
            for (int gI = 0; gI < 16; ++gI) if (gI < ngrp) {
#pragma unroll
                for (int q = 0; q < 8; ++q) { const unsigned k = key[gI * 8 + q];
                    const bool in = pass == 0 ? (k != 0u) : ((k >> 8) == prefix);
                    const unsigned bin = pass == 0 ? (k >> 8) : (k & 255u);
                    if (in) asm volatile("ds_add_u32 %0, %1" :: "v"(hbase + bin * 4u), "v"(1u) : "memory"); }
            }
            asm volatile("s_waitcnt lgkmcnt(0)" ::: "memory");
            const u32x4 h = *(const LAS u32x4*)(hist + lane * 4);
            const int sl = (int)(h.x + h.y + h.z + h.w), want = 256 - above;
            int run = 0, L = 63;
            for (; L > 0; --L) { const int v = __builtin_amdgcn_readlane(sl, L); if (run + v >= want) break; run += v; }
            int bin = 4 * L;
            { const int h3 = __builtin_amdgcn_readlane((int)h.w, L), h2 = __builtin_amdgcn_readlane((int)h.z, L), h1 = __builtin_amdgcn_readlane((int)h.y, L);
              if (run + h3 >= want) bin += 3; else { run += h3; if (run + h2 >= want) bin += 2; else { run += h2; if (run + h1 >= want) bin += 1; else run += h1; } } }
            above += run;
            if (pass == 0) prefix = (unsigned)bin; else thr = (prefix << 8) | (unsigned)bin;
        }
        ngt = above;
    }
    const int need = 256 - ngt; int bgt = 0, beq = 0;
#pragma unroll
    for (int gI = 0; gI < 16; ++gI) if (gI < ngrp) {
#pragma unroll
        for (int q = 0; q < 8; ++q) {
            const unsigned k = key[gI * 8 + q];
            const unsigned long long ms = __ballot(k >= thr);
            if (ms != 0ull) {
                const int s = gI * 512 + lane * 8 + q;
                const unsigned long long mg = __ballot(k > thr), me = ms & ~mg;
                const int rg = __builtin_amdgcn_mbcnt_hi((unsigned)(mg >> 32), __builtin_amdgcn_mbcnt_lo((unsigned)mg, 0u));
                const int re = __builtin_amdgcn_mbcnt_hi((unsigned)(me >> 32), __builtin_amdgcn_mbcnt_lo((unsigned)me, 0u));
                if (k > thr) li[bgt + rg] = (unsigned short)s;
                else if (k == thr && beq + re < need) li[ngt + beq + re] = (unsigned short)s;
                bgt += __popcll(mg); beq += __popcll(me);
            }
        }
    }
    asm volatile("s_waitcnt lgkmcnt(0)" ::: "memory");
    *(u32x2*)(idx + lane * 4) = *(const LAS u32x2*)(li + lane * 4);
}

__device__ __forceinline__ void attend_one(unsigned char* ws, LAS unsigned char* lds, int wave, int bb, int t, int kvh, int lane) {
    asm volatile("" : "+v"(lane));
    const int n = lane & 15, g = lane >> 4;
    const bf16_t* Kb = (const bf16_t*)(ws + WS_DK) + (size_t)(bb * 4 + kvh) * 8192 * 128;
    const bf16_t* Vb = (const bf16_t*)(ws + WS_DV) + (size_t)(bb * 4 + kvh) * 8192 * 128;
    bf16_t* qrow = (bf16_t*)(ws + WS_DQ) + (size_t)(bb * 8192 + t) * 2048 + kvh * 512;
    const unsigned short* ix = (const unsigned short*)(ws + WS_IDX) + (size_t)(bb * 8192 + t) * 256;
    const int cnt = t < 255 ? t + 1 : 256;
    LAS unsigned* li = (LAS unsigned*)(lds + wave * 1024);
    { const u32x2 iw = *(const u32x2*)(ix + lane * 4); *(LAS u32x4*)(li + lane * 4) = (u32x4){(iw.x & 0xffffu) << 8, (iw.x >> 16) << 8, (iw.y & 0xffffu) << 8, (iw.y >> 16) << 8}; }
    bf16x8 qf[4];
#pragma unroll
    for (int kk = 0; kk < 4; ++kk) { qf[kk] = (bf16x8){0, 0, 0, 0, 0, 0, 0, 0}; if (n < 4) qf[kk] = *(const bf16x8*)(qrow + n * 128 + kk * 32 + g * 8); }
    asm volatile("s_waitcnt vmcnt(0) lgkmcnt(0)" ::: "memory");
    bf16x8 ka[2][4][4];
#define ATT_LOADK(buf, grp) do { _Pragma("unroll") for (int tl = 0; tl < 4; ++tl) { const unsigned ko = li[((grp) * 4 + tl) * 16 + n] + (unsigned)g * 16u; \
        _Pragma("unroll") for (int kk = 0; kk < 4; ++kk) ka[buf][tl][kk] = *(const bf16x8*)((const char*)Kb + (ko + kk * 64u)); } } while (0)
    ATT_LOADK(0, 0); ATT_LOADK(1, 1);
    __builtin_amdgcn_sched_barrier(0);
    f32x4 S[16];
#pragma unroll
    for (int gi = 0; gi < 4; ++gi) {
#pragma unroll
        for (int tl = 0; tl < 4; ++tl) { f32x4 a = {0.f, 0.f, 0.f, 0.f};
#pragma unroll
            for (int kk = 0; kk < 4; ++kk) a = __builtin_amdgcn_mfma_f32_16x16x32_bf16(ka[gi & 1][tl][kk], qf[kk], a, 0, 0, 0);
            S[gi * 4 + tl] = a; }
        __builtin_amdgcn_sched_barrier(0);
        if (gi + 2 < 4) { ATT_LOADK(gi & 1, gi + 2); __builtin_amdgcn_sched_barrier(0); }
    }
#undef ATT_LOADK
    u32x4 R[3][8];
#define ATT_LOADV(buf, ks) do { const u32x4 i0 = *(const LAS u32x4*)(li + (ks) * 32 + 4 * g), i1 = *(const LAS u32x4*)(li + (ks) * 32 + 16 + 4 * g); \
        const unsigned kidx[8] = {i0.x, i0.y, i0.z, i0.w, i1.x, i1.y, i1.z, i1.w}; \
        _Pragma("unroll") for (int jj = 0; jj < 8; ++jj) R[buf][jj] = *(const u32x4*)((const char*)Vb + (kidx[jj] + (unsigned)n * 16u)); } while (0)
    ATT_LOADV(0, 0); ATT_LOADV(1, 1); ATT_LOADV(2, 2);
    __builtin_amdgcn_sched_barrier(0);
    if (cnt < 256) {
#pragma unroll
        for (int kt = 0; kt < 16; ++kt)
#pragma unroll
            for (int j = 0; j < 4; ++j) if (4 * g + j >= cnt - kt * 16) S[kt][j] = -3.0e38f;
    }
    f32x4 mx4 = S[0];
#pragma unroll
    for (int kt = 1; kt < 16; ++kt) mx4 = __builtin_elementwise_max(mx4, S[kt]);
    float mx = fmaxf(fmaxf(mx4[0], mx4[1]), fmaxf(mx4[2], mx4[3]));
    mx = fmaxf(mx, shx(mx, 16, lane)); mx = fmaxf(mx, shx(mx, 32, lane));
    f32x4 sum4 = {0.f, 0.f, 0.f, 0.f};
#pragma unroll
    for (int kt = 0; kt < 16; ++kt) { f32x4 d = S[kt] - mx;
#pragma unroll
        for (int j = 0; j < 4; ++j) d[j] = __builtin_amdgcn_exp2f(d[j]);
        S[kt] = d; sum4 += d; }
    float sum = (sum4[0] + sum4[1]) + (sum4[2] + sum4[3]);
    sum += shx(sum, 16, lane); sum += shx(sum, 32, lane);
    const float inv = 1.f / sum;
    u32x4 pa[8];
#pragma unroll
    for (int ks = 0; ks < 8; ++ks) pa[ks] = pack8(S[2 * ks], S[2 * ks + 1]);
    f32x4 O[8];
#pragma unroll
    for (int dt = 0; dt < 8; ++dt) O[dt] = (f32x4){0.f, 0.f, 0.f, 0.f};
    __builtin_amdgcn_sched_barrier(0);
#pragma unroll
    for (int ks = 0; ks < 8; ++ks) {
        const bf16x8 pk = __builtin_bit_cast(bf16x8, pa[ks]);
#pragma unroll
        for (int w = 0; w < 4; ++w) {
            u32x4 lo, hi;
#pragma unroll
            for (int a = 0; a < 4; ++a) { lo[a] = __builtin_amdgcn_perm(R[ks % 3][2 * a + 1][w], R[ks % 3][2 * a][w], 0x05040100u); hi[a] = __builtin_amdgcn_perm(R[ks % 3][2 * a + 1][w], R[ks % 3][2 * a][w], 0x07060302u); }
            O[2 * w] = __builtin_amdgcn_mfma_f32_16x16x32_bf16(pk, __builtin_bit_cast(bf16x8, lo), O[2 * w], 0, 0, 0);
            O[2 * w + 1] = __builtin_amdgcn_mfma_f32_16x16x32_bf16(pk, __builtin_bit_cast(bf16x8, hi), O[2 * w + 1], 0, 0, 0);
        }
        __builtin_amdgcn_sched_barrier(0);
        if (ks + 3 < 8) { ATT_LOADV(ks % 3, ks + 3); __builtin_amdgcn_sched_barrier(0); }
    }
#undef ATT_LOADV
#pragma unroll
    for (int j = 0; j < 4; ++j) {
        const float iv = __int_as_float(__builtin_amdgcn_readlane(__float_as_int(inv), j));
        if (g == 0) { f32x4 a = {O[0][j] * iv, O[1][j] * iv, O[2][j] * iv, O[3][j] * iv}, b = {O[4][j] * iv, O[5][j] * iv, O[6][j] * iv, O[7][j] * iv};
            st8bf(qrow + j * 128 + n * 8, a, b); }
    }
}

__device__ __forceinline__ float log_a_of(const LAS float* glr, const float (&w)[16], float bgc) {
    float z = bgc;
    const f32x4 g0 = *(const LAS f32x4*)glr, g1 = *(const LAS f32x4*)(glr + 4), g2 = *(const LAS f32x4*)(glr + 8), g3 = *(const LAS f32x4*)(glr + 12);
#pragma unroll
    for (int k = 0; k < 4; ++k) z += g0[k] * w[k] + g1[k] * w[4 + k] + g2[k] * w[8 + k] + g3[k] * w[12 + k];
    return -(fmaxf(-z, 0.f) + __logf(1.f + __expf(-fabsf(z)))) * 0.0625f;
}
__device__ __forceinline__ void gla_prep(const Args& A, LAS float* sm, int uu, int tid) {
    unsigned char* ws = A.ws;
    const int ch = tid & 255, half = __builtin_amdgcn_readfirstlane(tid >> 8);
    const int c = uu & 31, h = (uu >> 5) & 3, b = uu >> 7;
    const int tok0 = b * 8192 + c * 256 + half * 128;
    float w[16];
#pragma unroll
    for (int k = 0; k < 16; ++k) w[k] = A.gla_wg2[k * 1024 + h * 256 + ch];
    const float bgc = A.gla_bg[h * 256 + ch];
    {
        const f32x4* src = (const f32x4*)((const float*)(ws + WS_GLR) + (size_t)(b * 8192 + c * 256) * 16);
        LAS f32x4* dst = (LAS f32x4*)(sm + 1024);
        dst[tid] = src[tid]; dst[tid + 512] = src[tid + 512];
    }
    __syncthreads();
    const LAS float* GLR = sm + 1024 + half * 128 * 16;
    float s = 0.f;
#pragma unroll 4
    for (int tt = 0; tt < 128; ++tt) s += log_a_of(GLR + tt * 16, w, bgc);
    sm[half * 256 + ch] = s;
    __syncthreads();
    const float tot0 = sm[ch], blast = sm[ch] + sm[256 + ch];
    __syncthreads();
    if (half == 0) ((float*)(ws + WS_BLAST))[uu * 256 + ch] = blast;
    float bcur = half ? tot0 : 0.f;
    const bf16_t* GQ = (const bf16_t*)(ws + WS_GQ); bf16_t* GK = (bf16_t*)(ws + WS_GK);
    bf16_t* QS = (bf16_t*)(ws + WS_QS) + (size_t)uu * 256 * 256; bf16_t* KT = (bf16_t*)(ws + WS_KT) + ((size_t)uu * 256 + ch) * 256 + half * 128;
    unsigned short qn[8], kn[8];
#pragma unroll
    for (int q = 0; q < 8; ++q) { const size_t o = (size_t)(tok0 + q) * 1024 + h * 256 + ch; qn[q] = GQ[o]; kn[q] = GK[o]; }
    for (int t8 = 0; t8 < 16; ++t8) {
        float kp[8], qv[8], kv[8];
#pragma unroll
        for (int q = 0; q < 8; ++q) { qv[q] = bf2f(qn[q]); kv[q] = bf2f(kn[q]); }
        if (t8 < 15) {
#pragma unroll
            for (int q = 0; q < 8; ++q) { const size_t o = (size_t)(tok0 + (t8 + 1) * 8 + q) * 1024 + h * 256 + ch; qn[q] = GQ[o]; kn[q] = GK[o]; }
        }
#pragma unroll
        for (int q = 0; q < 8; ++q) {
            const int tt = t8 * 8 + q; const size_t tok = (size_t)(tok0 + tt);
            bcur += log_a_of(GLR + tt * 16, w, bgc);
            const float eb = __expf(bcur), ieb = __expf(-bcur);
            QS[(size_t)(half * 128 + tt) * 256 + ch] = f2bf(qv[q] * eb);
            kp[q] = kv[q] * ieb;
            GK[tok * 1024 + h * 256 + ch] = f2bf(kp[q]);
        }
        u32x4 o; o.x = cvt_pk_bf16(kp[0], kp[1]); o.y = cvt_pk_bf16(kp[2], kp[3]); o.z = cvt_pk_bf16(kp[4], kp[5]); o.w = cvt_pk_bf16(kp[6], kp[7]);
        *(u32x4*)(KT + t8 * 8) = o;
    }
}
__device__ __forceinline__ void gla_scan(unsigned char* ws, int gt, int NGT) {
    const float* BL = (const float*)(ws + WS_BLAST);
    for (int it = gt; it < 8 * 512 * 32; it += NGT) {
        const int d8 = it & 31, e = (it >> 5) & 511, bh = it >> 14;
        float S[8];
#pragma unroll
        for (int q = 0; q < 8; ++q) S[q] = 0.f;
        for (int c0 = 0; c0 < 32; c0 += 4) {
            u32x4 uw[4]; f32x4 d0[4], d1[4];
#pragma unroll
            for (int k = 0; k < 4; ++k) { const int uu = bh * 32 + c0 + k;
                uw[k] = *(const u32x4*)((const bf16_t*)(ws + WS_ST) + ((size_t)uu * 512 + e) * 256 + d8 * 8);
                d0[k] = *(const f32x4*)(BL + uu * 256 + d8 * 8); d1[k] = *(const f32x4*)(BL + uu * 256 + d8 * 8 + 4); }
#pragma unroll
            for (int k = 0; k < 4; ++k) { const int uu = bh * 32 + c0 + k;
                u32x4 o; o.x = cvt_pk_bf16(S[0], S[1]); o.y = cvt_pk_bf16(S[2], S[3]); o.z = cvt_pk_bf16(S[4], S[5]); o.w = cvt_pk_bf16(S[6], S[7]);
                *(u32x4*)((bf16_t*)(ws + WS_ST) + ((size_t)uu * 512 + e) * 256 + d8 * 8) = o;
                S[0] = S[0] * __expf(d0[k][0]) + bflo(uw[k].x); S[1] = S[1] * __expf(d0[k][1]) + bfhi(uw[k].x); S[2] = S[2] * __expf(d0[k][2]) + bflo(uw[k].y); S[3] = S[3] * __expf(d0[k][3]) + bfhi(uw[k].y);
                S[4] = S[4] * __expf(d1[k][0]) + bflo(uw[k].z); S[5] = S[5] * __expf(d1[k][1]) + bfhi(uw[k].z); S[6] = S[6] * __expf(d1[k][2]) + bflo(uw[k].w); S[7] = S[7] * __expf(d1[k][3]) + bfhi(uw[k].w); }
        }
    }
}
__device__ __forceinline__ void gla_post(const Args& A, int gw, int NGW, int lane) {
    unsigned char* ws = A.ws;
    const f32x4 g0 = *(const f32x4*)(A.gla_norm_g + lane * 8), g1 = *(const f32x4*)(A.gla_norm_g + lane * 8 + 4);
    for (int it0 = gw * 4; it0 < T * 4; it0 += NGW * 4) {
        u32x4 xw[4], gw4[4];
#pragma unroll
        for (int k = 0; k < 4; ++k) { const int it = it0 + k; const size_t o = (size_t)(it >> 2) * 2048 + (it & 3) * 512 + lane * 8;
            xw[k] = *(const u32x4*)((const bf16_t*)(ws + WS_OG) + o); gw4[k] = *(const u32x4*)((const bf16_t*)(ws + WS_GR) + o); }
#pragma unroll
        for (int k = 0; k < 4; ++k) { const int it = it0 + k; const size_t o = (size_t)(it >> 2) * 2048 + (it & 3) * 512 + lane * 8;
            f32x4 x0 = {bflo(xw[k].x), bfhi(xw[k].x), bflo(xw[k].y), bfhi(xw[k].y)}, x1 = {bflo(xw[k].z), bfhi(xw[k].z), bflo(xw[k].w), bfhi(xw[k].w)};
            const f32x4 r0 = {bflo(gw4[k].x), bfhi(gw4[k].x), bflo(gw4[k].y), bfhi(gw4[k].y)}, r1 = {bflo(gw4[k].z), bfhi(gw4[k].z), bflo(gw4[k].w), bfhi(gw4[k].w)};
            float ss = 0.f;
#pragma unroll
            for (int q = 0; q < 4; ++q) ss += x0[q] * x0[q] + x1[q] * x1[q];
            const float rstd = rsqrtf(wave_sum(ss, lane) * (1.f / 512.f) + EPS);
            x0 = x0 * rstd * g0 * r0; x1 = x1 * rstd * g1 * r1;
            *(u32x4*)((bf16_t*)(ws + WS_OG) + o) = pack8(x0, x1); }
    }
}

#define XB_TMO      128
#define XB_XCNT(j)  (256  + 64 * (j))
#define XB_XSUB(j)  (1280 + 64 * (j))
#define XB_XGEN(j)  (2304 + 64 * (j))
#define XB_TOP      3328
#define XB_TOPGEN   3392
#define XCD_BAR_WORDS 3456
#define XB_SPIN_CAP (1u << 22)
#define RLX_AGENT __ATOMIC_RELAXED, __HIP_MEMORY_SCOPE_AGENT
__device__ __forceinline__ unsigned xb_ld(unsigned* p)              { return __hip_atomic_load(p, RLX_AGENT); }
__device__ __forceinline__ unsigned xb_add(unsigned* p, unsigned v) { return __hip_atomic_fetch_add(p, v, RLX_AGENT); }
__device__ __forceinline__ unsigned xb_xcc_id() { return (unsigned)__builtin_amdgcn_s_getreg((3 << 11) | 20) & 0xFu; }
#define XB_SPIN(cond, bar) do { unsigned _sp = 0; while (cond) { __builtin_amdgcn_s_sleep(1); \
    if ((++_sp & 255u) == 0u) { if (xb_ld(&(bar)[XB_TMO])) break; if (_sp > XB_SPIN_CAP) { atomicAdd(&(bar)[XB_TMO], 1u); break; } } } } while (0)
__device__ __forceinline__ void xcd_barrier_complete(unsigned* bar, unsigned x, unsigned G, unsigned& nloc, unsigned& nx) {
    unsigned sum, cnt, mine, sp = 0u;
    for (;;) {
        sum = 0u; cnt = 0u; mine = 0u;
#pragma unroll
        for (unsigned j = 0; j < 16; ++j) { const unsigned c = xb_ld(&bar[XB_XCNT(j)]); sum += c; cnt += (c > 0u) ? 1u : 0u; mine = (j == x) ? c : mine; }
        if (sum == G) break;
        __builtin_amdgcn_s_sleep(1);
        if ((++sp & 255u) == 0u) { if (xb_ld(&bar[XB_TMO])) break; if (sp > XB_SPIN_CAP) { atomicAdd(&bar[XB_TMO], 1u); break; } }
    }
    nloc = mine > 0u ? mine : 1u; nx = cnt > 0u ? cnt : 1u;
}
__device__ __forceinline__ void grid_bar(unsigned* bar, volatile LAS unsigned* st, unsigned G, int wave) {
    asm volatile("s_waitcnt vmcnt(0) lgkmcnt(0)" ::: "memory");
    __syncthreads();
    int l; asm volatile("v_mbcnt_lo_u32_b32 %0, -1, 0\n\tv_mbcnt_hi_u32_b32 %0, -1, %0" : "=v"(l));
    if (wave == 0 && l == 0) {
        const unsigned x = xb_xcc_id();
        __builtin_amdgcn_s_waitcnt(0);
        unsigned nloc = st[0], nx = st[1];
        if (nloc == 0u) { xcd_barrier_complete(bar, x, G, nloc, nx); st[0] = nloc; st[1] = nx; }
        const unsigned old = xb_add(&bar[XB_XSUB(x)], 1u);
        const unsigned gen = old / nloc;
        if (old + 1u == (gen + 1u) * nloc) {
            __builtin_amdgcn_fence(__ATOMIC_RELEASE, "agent");
            asm volatile("s_waitcnt vmcnt(0)" ::: "memory");
            const unsigned og = xb_add(&bar[XB_TOP], 1u);
            const unsigned tg = og / nx;
            if (og + 1u == (tg + 1u) * nx) xb_add(&bar[XB_TOPGEN], 1u);
            else XB_SPIN(xb_ld(&bar[XB_TOPGEN]) == tg, bar);
            __builtin_amdgcn_fence(__ATOMIC_ACQUIRE, "agent");
            xb_add(&bar[XB_XGEN(x)], 1u);
            asm volatile("s_waitcnt vmcnt(0)" ::: "memory");
        } else {
            XB_SPIN(xb_ld(&bar[XB_XGEN(x)]) == gen, bar);
            __builtin_amdgcn_fence(__ATOMIC_ACQUIRE, "agent");
            asm volatile("s_waitcnt vmcnt(0)" ::: "memory");
        }
    }
    __syncthreads();
}
__device__ __forceinline__ Args load_args() {
    Args a{};
#if defined(__HIP_DEVICE_COMPILE__)
    const __attribute__((address_space(4))) unsigned long long* q = (const __attribute__((address_space(4))) unsigned long long*)__builtin_amdgcn_kernarg_segment_ptr();
    asm volatile("" : "+s"(q));
    unsigned long long* d = (unsigned long long*)&a;
#pragma unroll
    for (int i = 0; i < (int)(sizeof(Args) / 8); ++i) d[i] = q[i];
#endif
    return a;
}
__global__ void __launch_bounds__(512, 2) hybrid_fwd(Args A0) {
    extern __shared__ __attribute__((aligned(16))) unsigned char lds_raw[];
    LAS unsigned char* lds = (LAS unsigned char*)lds_raw;
    cg::grid_group grid = cg::this_grid();
    unsigned char* ws = A0.ws; const int ph_lo = A0.ph_lo, ph_hi = A0.ph_hi;
    const int G = gridDim.x, bid = blockIdx.x;
    const int NGW = G * 8;
    const int wave = __builtin_amdgcn_readfirstlane(threadIdx.x >> 6);
    const Gemm gws{(const bf16_t*)ws, (const bf16_t*)ws, 256, 256, 256};
    int ph = 0;
    volatile LAS unsigned* bst = (volatile LAS unsigned*)(lds + 131072);
    { int l0; asm volatile("v_mbcnt_lo_u32_b32 %0, -1, 0\n\tv_mbcnt_hi_u32_b32 %0, -1, %0" : "=v"(l0));
      if (wave == 0 && l0 == 0) { const unsigned x0 = xb_xcc_id(); bst[0] = 0u; bst[1] = 0u; bst[3] = x0; bst[2] = xb_add(&((unsigned*)ws)[XB_XCNT(x0)], 1u); } }
    grid.sync();
#ifndef PHMASK
#define PHMASK 0xffffffffu
#endif
#define PHASE_BEGIN(id) if (((PHMASK >> (id)) & 1u) && ph >= ph_lo && ph < ph_hi) { const Args A = load_args(); int lane; asm volatile("v_mbcnt_lo_u32_b32 %0, -1, 0\n\tv_mbcnt_hi_u32_b32 %0, -1, %0" : "=v"(lane)); const int tid = wave * 64 + lane, gw = bid * 8 + wave; (void)tid; LAS float* scr = (LAS float*)(lds + wave * 16384); (void)lane; (void)gw; (void)scr;
#define PHASE_END_NOBAR } ++ph; __syncthreads();
#define PHASE_END } ++ph; if (ph > ph_lo && ph < ph_hi) { grid_bar((unsigned*)ws, bst, (unsigned)G, wave); }

    PHASE_BEGIN(0)
        for (int it = gw; it < 32 * (NPROJ / 32); it += NGW) transpose_item<true>(A.w_in, DM, NPROJ, (bf16_t*)(ws + WS_WTIN), scr, it, lane);
        for (int m = gw * 4; m < T; m += NGW * 4) rms_row2_bf16(A.x + (size_t)m * DM, A.norm1_g, (bf16_t*)(ws + WS_H) + (size_t)m * DM, lane);
        for (int i = bid * 512 + tid; i < T; i += G * 512) ((float*)(ws + WS_RSS))[i] = 0.f;
        for (int i = bid * 512 + tid; i < SEQ * 96; i += G * 512) {
            const int pos = i / 96, j = i % 96;
            if (j < 64) { const float f = powf(10000.f, -(float)j * 2.0f / 128.f); const float a = (float)pos * f; float sn, cs; sincosf(a, &sn, &cs);
                ((float*)(ws + WS_ROPE1))[(size_t)pos * 128 + j * 2] = cs; ((float*)(ws + WS_ROPE1))[(size_t)pos * 128 + j * 2 + 1] = sn; }
            else { const int jj = j - 64; const float f = powf(10000.f, -(float)jj * 2.0f / 64.f); const float a = (float)pos * f; float sn, cs; sincosf(a, &sn, &cs);
                ((float*)(ws + WS_ROPE2))[(size_t)pos * 64 + jj * 2] = cs; ((float*)(ws + WS_ROPE2))[(size_t)pos * 64 + jj * 2 + 1] = sn; }
        }
    PHASE_END
    PHASE_BEGIN(1)
        const Gemm g{(const bf16_t*)(ws + WS_H), (const bf16_t*)(ws + WS_WTIN), DM, DM, DM};
        pg8::StaticOrder S; S.init(T, NPROJ_PAD, DM, DM, G, bid);
        Epi<M_INPROJ> E{&A, 0};
        pg8::gemm_phase<Epi<M_INPROJ>, pg8::StaticOrder, true>(lds, g, S, E, wave);
    PHASE_END
    PHASE_BEGIN(2)
        post_proj(A, gw, NGW, lane);
    PHASE_END
#define DSA_ROUND(bb, ATT_END) \
        PHASE_BEGIN(3) \
            idx_stream(ws, lds, bb, bid, G, wave, lane, tid); \
        PHASE_END \
        PHASE_BEGIN(4) \
            for (int t = gw; t < SEQ; t += NGW) \
                select_one((const unsigned short*)(ws + WS_SC) + (size_t)t * SEQ, t, (unsigned short*)(ws + WS_IDX) + (size_t)(bb * SEQ + t) * 256, lane, (LAS unsigned short*)(lds + wave * 512), (LAS unsigned*)(lds + 4096 + wave * 1024)); \
        PHASE_END \
        PHASE_BEGIN(5) \
            const bool xl = (G == 256) && bst[0] == 32u && bst[1] == 8u && bst[3] < 8u; const int xq = (int)bst[3], kvh0 = xq & 3, qh = (xq >> 2) & 1, lw = (int)bst[2] * 8 + wave; \
            for (int it = gw, k = 0; xl ? (k < 16) : (it < SEQ * 4); it += NGW, ++k) attend_one(ws, lds, wave, bb, xl ? (lw + 256 * k) * 2 + qh : (it >> 2), xl ? kvh0 : (it & 3), lane); \
        ATT_END
    DSA_ROUND(0, PHASE_END_NOBAR)
    DSA_ROUND(1, PHASE_END)
#undef DSA_ROUND
    PHASE_BEGIN(6)
        for (int uu = bid; uu < 256; uu += G) { gla_prep(A, (LAS float*)lds, uu, tid); __syncthreads(); }
    PHASE_END
    PHASE_BEGIN(7)
        { G0Order S{G, bid}; Epi<M_G0> E{&A, 0}; pg8::gemm_phase<Epi<M_G0>, G0Order, true>(lds, gws, S, E, wave); }
        { Gemm g1 = gws; g1.lda = 256; g1.ldb = 1024; G1Order S{G, bid}; Epi<M_G1> E{&A, 0}; pg8::gemm_phase<Epi<M_G1>, G1Order, true>(lds, g1, S, E, wave); }
    PHASE_END
    PHASE_BEGIN(8)
        gla_scan(ws, bid * 512 + tid, G * 512);
    PHASE_END
    PHASE_BEGIN(9)
        G2Order S{G, bid}; Epi<M_G2> E{&A, 0}; pg8::gemm_phase<Epi<M_G2>, G2Order, true>(lds, gws, S, E, wave);
    PHASE_END
    PHASE_BEGIN(10)
        gla_post(A, gw, NGW, lane);
        constexpr int I_P = 32 * 64, I_F = 32 * 256;
        for (int it = gw; it < 3 * I_P + 2 * I_F; it += NGW) {
            int r = it;
            if (r < I_P) { transpose_item<false>(A.w_proj_gla, 2048, 2048, (bf16_t*)(ws + WS_WPG), scr, r, lane); continue; } r -= I_P;
            if (r < I_P) { transpose_item<false>(A.w_proj_dsa, 2048, 2048, (bf16_t*)(ws + WS_WPD), scr, r, lane); continue; } r -= I_P;
            if (r < I_P) { transpose_item<false>(A.w_out, 2048, 2048, (bf16_t*)(ws + WS_WO), scr, r, lane); continue; } r -= I_P;
            if (r < I_F) { transpose_item<false>(A.w_ff1, 2048, 8192, (bf16_t*)(ws + WS_WF1), scr, r, lane, A.norm2_g); continue; }     r -= I_F;
            transpose_item<false>(A.w_ff2, 8192, 2048, (bf16_t*)(ws + WS_WF2), scr, r, lane);
        }
    PHASE_END
    PHASE_BEGIN(11)
        Gemm g = gws; g.lda = 2048; g.ldb = 2048; g.K = 2048;
        MergeOrder S; S.so.init(T, DM, DM, DM, G, bid, 4); Epi<M_MERGE> E{&A, 0};
        pg8::gemm_phase<Epi<M_MERGE>, MergeOrder, true>(lds, g, S, E, wave);
    PHASE_END
    PHASE_BEGIN(12)
        const Gemm g{(const bf16_t*)(ws + WS_U), (const bf16_t*)(ws + WS_WO), DM, DM, DM};
        pg8::StaticOrder S; S.init(T, DM, DM, DM, G, bid, 4); Epi<M_OUT> E{&A, 0};
        pg8::gemm_phase<Epi<M_OUT>, pg8::StaticOrder, true>(lds, g, S, E, wave);
    PHASE_END
    PHASE_BEGIN(14)
        const Gemm g{(const bf16_t*)(ws + WS_H2), (const bf16_t*)(ws + WS_WF1), DM, DM, DM};
        pg8::StaticOrder S; S.init(T, DFF, DM, DM, G, bid); Epi<M_FF1> E{&A, 0};
        pg8::gemm_phase<Epi<M_FF1>, pg8::StaticOrder, true>(lds, g, S, E, wave);
    PHASE_END
    PHASE_BEGIN(15)
        const Gemm g{(const bf16_t*)(ws + WS_HM), (const bf16_t*)(ws + WS_WF2), DFF, DFF, DFF};
        pg8::StaticOrder S; S.init(T, DM, DFF, DFF, G, bid, 4); Epi<M_FF2> E{&A, 0};
        pg8::gemm_phase<Epi<M_FF2>, pg8::StaticOrder, true>(lds, g, S, E, wave);
    PHASE_END
}

constexpr int LDS_BYTES = 131072 + 4096;
extern "C" void kernel_launch(void* const* d_in, const int* in_sizes, int n_in, void* d_out, int out_size, void* d_ws, size_t ws_size, hipStream_t stream) {
    static int grid = 0;
    if (grid == 0) {
        if (n_in != 16 || ws_size < WS_NEED) { fprintf(stderr, "kernel_launch: need 16 inputs and >= %zu bytes of workspace (got %d, %zu)\n", (size_t)WS_NEED, n_in, ws_size); grid = -1; return; }
        int dev = 0, cus = 0, per_cu = 0;
        hipGetDevice(&dev); hipDeviceGetAttribute(&cus, hipDeviceAttributeMultiprocessorCount, dev);
        if (hipFuncSetAttribute((const void*)hybrid_fwd, hipFuncAttributeMaxDynamicSharedMemorySize, LDS_BYTES) != hipSuccess) { fprintf(stderr, "kernel_launch: hipFuncSetAttribute failed\n"); grid = -1; return; }
        if (hipOccupancyMaxActiveBlocksPerMultiprocessor(&per_cu, (const void*)hybrid_fwd, 512, LDS_BYTES) != hipSuccess || per_cu < 1) { fprintf(stderr, "kernel_launch: occupancy query gave %d\n", per_cu); per_cu = 1; }
        (void)hipGetLastError();
        grid = cus * 1;
    }
    if (grid < 0) return;
    Args a{};
    const float** f = (const float**)&a;
    for (int i = 0; i < 16; ++i) f[i] = (const float*)d_in[i];
    a.out = (float*)d_out; a.ws = (unsigned char*)d_ws; a.ph_lo = 0; a.ph_hi = 1000;
    if (hipMemsetAsync(d_ws, 0, 16384, stream) != hipSuccess) { fprintf(stderr, "kernel_launch: memset failed\n"); return; }
    void* args[] = {&a};
    hipError_t e = hipLaunchCooperativeKernel((const void*)hybrid_fwd, dim3(grid), dim3(512), args, LDS_BYTES, stream);
    if (e != hipSuccess) fprintf(stderr, "cooperative launch failed: %s (grid %d)\n", hipGetErrorString(e), grid);
}
```

```cpp
#include <hip/hip_runtime.h>
#include <hip/hip_cooperative_groups.h>
#include <cstdio>
#include <cstdint>
namespace cg = cooperative_groups;

#define LAS __attribute__((address_space(3)))
typedef unsigned short bf16_t;
typedef short bf16x8 __attribute__((ext_vector_type(8)));
typedef float f32x4 __attribute__((ext_vector_type(4)));
typedef unsigned u32x4 __attribute__((ext_vector_type(4)));
typedef unsigned u32x2 __attribute__((ext_vector_type(2)));

constexpr int T = 16384, SEQ = 8192, DM = 2048, DFF = 8192, NPROJ = 15520, NPROJ_PAD = 15616;
constexpr float EPS = 1e-6f;
constexpr size_t MiB = 1u << 20;
constexpr size_t WS_GLR = 1 * MiB, WS_IW = 2 * MiB, WS_BLAST = 3 * MiB, WS_ROPE1 = 4 * MiB, WS_ROPE2 = 8 * MiB, WS_IK = 10 * MiB, WS_IDX = 14 * MiB, WS_CNT = 22 * MiB;
constexpr size_t WS_GQ = 24 * MiB, WS_GK = 56 * MiB, WS_VT = 88 * MiB, WS_GR = 152 * MiB, WS_DQ = 216 * MiB, WS_DK = 280 * MiB, WS_DV = 296 * MiB, WS_IQ = 312 * MiB;
constexpr size_t WS_WTIN = 376 * MiB, WS_H = 437 * MiB;
constexpr size_t WS_SC = 376 * MiB;
constexpr size_t WS_QS = 280 * MiB, WS_P = 312 * MiB, WS_ST = 344 * MiB, WS_KT = 408 * MiB, WS_OG = 440 * MiB;
constexpr size_t WS_WPG = 24 * MiB, WS_WPD = 32 * MiB, WS_WO = 40 * MiB, WS_WF1 = 48 * MiB, WS_WF2 = 80 * MiB;
constexpr size_t WS_U = 280 * MiB, WS_H2 = 440 * MiB, WS_HM = 112 * MiB;
constexpr size_t WS_RSS = 22 * MiB;
constexpr size_t WS_NEED = 512 * MiB;

__device__ __forceinline__ unsigned cvt_pk_bf16(float lo, float hi) { unsigned r; asm volatile("v_cvt_pk_bf16_f32 %0, %1, %2" : "=v"(r) : "v"(lo), "v"(hi)); return r; }
__device__ __forceinline__ float bf2f(unsigned short b) { return __uint_as_float(((unsigned)b) << 16); }
__device__ __forceinline__ float bflo(unsigned w) { return __uint_as_float(w << 16); }
__device__ __forceinline__ float bfhi(unsigned w) { return __uint_as_float(w & 0xffff0000u); }
__device__ __forceinline__ unsigned short f2bf(float f) { return (unsigned short)(cvt_pk_bf16(f, 0.f) & 0xffffu); }
__device__ __forceinline__ float shx(float v, int m, int lane) { return __int_as_float(__builtin_amdgcn_ds_bpermute((lane ^ m) << 2, __float_as_int(v))); }
#define DPPF(v, ctrl) __int_as_float(__builtin_amdgcn_update_dpp(0, __float_as_int(v), (ctrl), 0xf, 0xf, false))
__device__ __forceinline__ float row16_sum(float x) { x += DPPF(x, 0xB1); x += DPPF(x, 0x4E); x += DPPF(x, 0x141); x += DPPF(x, 0x140); return x; }
__device__ __forceinline__ float wave_sum(float v, int lane) {
    (void)lane; const float x = row16_sum(v);
    return (__int_as_float(__builtin_amdgcn_readlane(__float_as_int(x), 0)) + __int_as_float(__builtin_amdgcn_readlane(__float_as_int(x), 16)))
         + (__int_as_float(__builtin_amdgcn_readlane(__float_as_int(x), 32)) + __int_as_float(__builtin_amdgcn_readlane(__float_as_int(x), 48)));
}
__device__ __forceinline__ u32x4 pack8(f32x4 a, f32x4 b) { u32x4 w; w.x = cvt_pk_bf16(a[0], a[1]); w.y = cvt_pk_bf16(a[2], a[3]); w.z = cvt_pk_bf16(b[0], b[1]); w.w = cvt_pk_bf16(b[2], b[3]); return w; }

namespace pg8 {
constexpr int BM = 256, BK = 64, HALF = 128, HTB = HALF * BK * 2, STAGE_BYTES = 8 * HTB, NXCD = 8, WGM = 8;
__host__ __device__ __forceinline__ int lds_byte(int r, int c) { const int st = (r >> 4) * 2 + (c >> 5), rr = r & 15, cc = c & 31, ob = rr * 64 + cc * 2; return st * 1024 + (ob ^ (((ob >> 9) & 1) << 5)); }
__host__ __device__ __forceinline__ void stage_rc(int b, int& R, int& C) { const int st = b / 1024, sb = b % 1024, swz = sb ^ (((sb >> 9) & 1) << 5); R = (st >> 1) * 16 + swz / 64; C = (st & 1) * 32 + (swz % 64) / 2; }
__host__ __device__ __forceinline__ int perm32(int rho) { const int n = rho >> 4, i = rho & 15; return 8 * (i >> 2) + 4 * n + (i & 3); }

__device__ __forceinline__ void glds16s(const void* sbase, unsigned voff, unsigned lds_dst) { unsigned keep;
    asm volatile("s_mov_b32 %0, m0\n\ts_mov_b32 m0, %3\n\ts_nop 0\n\tglobal_load_lds_dwordx4 %1, %2\n\ts_mov_b32 m0, %0" : "=&s"(keep) : "v"(voff), "s"(sbase), "s"(lds_dst) : "memory"); }
struct Unit { int pm, pn; long offA, offB; int chain, aux; };
struct Gemm { const bf16_t* A; const bf16_t* Bt; int lda, ldb, K; };

struct StaticOrder {
    int nM, nN, nwg, G, c, wgm; long sA, sB;
    __device__ void init(int M, int N, int lda, int ldb, int G_, int c_, int wgm_ = WGM) { nM = M / BM; nN = N / BM; nwg = nM * nN; G = G_; c = c_; wgm = wgm_; sA = (long)BM * lda * 2; sB = (long)BM * ldb * 2; }
    __device__ bool next(int i, Unit& u) const {
        const long L = (long)i * G + c; if (L >= nwg) return false;
        int wgid = (int)L; { const int q = nwg / NXCD, r = nwg % NXCD, xcd = wgid % NXCD, off = wgid / NXCD; wgid = (xcd < r ? xcd * (q + 1) : r * (q + 1) + (xcd - r) * q) + off; }
        const int nig = wgm * nN, gid = wgid / nig, fm = gid * wgm, gsz = (nM - fm) < wgm ? (nM - fm) : wgm;
        u.pm = fm + ((wgid % nig) % gsz); u.pn = (wgid % nig) / gsz; u.offA = u.pm * sA; u.offB = u.pn * sB; u.chain = 0; u.aux = 0; return true;
    }
};

template <class Epi, class Sched, bool ALIGN_EPI>
__device__ __forceinline__ void gemm_phase(LAS unsigned char* lds, const Gemm g, const Sched& S, const Epi& E, int wid) {
    int lane; asm volatile("v_mbcnt_lo_u32_b32 %0, -1, 0\n\tv_mbcnt_hi_u32_b32 %0, -1, %0" : "=v"(lane));
    const int tid = wid * 64 + lane; const int wr = wid >> 2, wc = wid & 3, fr = lane & 15, fq = lane >> 4;
    const int K = g.K, nt = K / BK;
    unsigned voffA[2], voffB[2];
#pragma unroll
    for (int i = 0; i < 2; ++i) { int R, C; stage_rc(tid * 16 + i * 8192, R, C); const int Rb = (R & ~31) + perm32(R & 31);
        voffA[i] = (unsigned)(R * g.lda + C) * 2u; voffB[i] = (unsigned)(Rb * g.ldb + C) * 2u; }
    const size_t kstep = (size_t)(BK * 2);
    const size_t hstepA = (size_t)HALF * g.lda * 2, hstepB = (size_t)HALF * g.ldb * 2;
    const unsigned ldsw = (unsigned)wid * 1024u;
    const int aoff = lds_byte(wr * 64 + fr, fq * 8), boff = lds_byte(wc * 32 + fr, fq * 8);
#define PG8_SA(b, h) (((b) * 2 + (h)) * HTB)
#define PG8_SB(b, h) ((4 + (b) * 2 + (h)) * HTB)
#define PG8_STAGE(bufoff, gbase, voff) do { _Pragma("unroll") for (int _i = 0; _i < 2; ++_i) \
        glds16s((const void*)(gbase), (voff)[_i], (unsigned)(size_t)(lds + (bufoff) + ldsw + _i * 8192)); } while (0)
#define PG8_LDA(dst, b, h) do { _Pragma("unroll") for (int m = 0; m < 4; ++m) _Pragma("unroll") for (int k = 0; k < 2; ++k) dst[m][k] = *(const LAS bf16x8*)(lds + PG8_SA(b, h) + aoff + m * 2048 + k * 1024); } while (0)
#define PG8_LDB(dst, b, h) do { _Pragma("unroll") for (int n = 0; n < 2; ++n) _Pragma("unroll") for (int k = 0; k < 2; ++k) dst[n][k] = *(const LAS bf16x8*)(lds + PG8_SB(b, h) + boff + n * 2048 + k * 1024); } while (0)
#define PG8_MMA(ai, bj, At, Bt) do { __builtin_amdgcn_s_setprio(1); _Pragma("unroll") for (int m = 0; m < 4; ++m) _Pragma("unroll") for (int n = 0; n < 2; ++n) _Pragma("unroll") for (int k = 0; k < 2; ++k) \
        acc[ai][bj][m][n] = __builtin_amdgcn_mfma_f32_16x16x32_bf16(Bt[n][k], At[m][k], acc[ai][bj][m][n], 0, 0, 0); __builtin_amdgcn_s_setprio(0); } while (0)
#define PG8_WAIT_V(n) asm volatile("s_waitcnt vmcnt(" #n ")" ::: "memory")
#define PG8_WAIT_L(n) asm volatile("s_waitcnt lgkmcnt(" #n ")" ::: "memory")
#define PG8_BAR __builtin_amdgcn_s_barrier()
#define PG8_SCHED __builtin_amdgcn_sched_barrier(0)
    Unit cur, nxt; int ui = 0;
    if (!S.next(0, cur)) return;
    f32x4 acc[2][2][4][2];
#pragma unroll
    for (int a = 0; a < 2; ++a)
#pragma unroll
        for (int b = 0; b < 2; ++b)
#pragma unroll
            for (int m = 0; m < 4; ++m)
#pragma unroll
                for (int n = 0; n < 2; ++n) acc[a][b][m][n] = (f32x4){0.f, 0.f, 0.f, 0.f};
    bf16x8 At[4][2], B0[2][2], B1[2][2];
    const char* cA = (const char*)g.A + cur.offA; const char* cB = (const char*)g.Bt + cur.offB;
    PG8_STAGE(PG8_SB(0, 0), cB, voffB); PG8_STAGE(PG8_SB(0, 1), cB + hstepB, voffB); PG8_STAGE(PG8_SA(0, 0), cA, voffA); PG8_STAGE(PG8_SA(0, 1), cA + hstepA, voffA);
    if (wr == 1) PG8_BAR;
    PG8_WAIT_V(2); PG8_BAR;
    PG8_STAGE(PG8_SB(1, 0), cB + kstep, voffB); PG8_STAGE(PG8_SA(1, 0), cA + kstep, voffA); PG8_STAGE(PG8_SB(1, 1), cB + hstepB + kstep, voffB);
    PG8_WAIT_V(6); PG8_BAR;
    for (;;) {
        const bool has_next = S.next(ui + 1, nxt);
        const char* nA = has_next ? (const char*)g.A + nxt.offA : cA; const char* nB = has_next ? (const char*)g.Bt + nxt.offB : cB;
        for (int t = 0; t < nt; t += 2) {
            const bool last = (t == nt - 2);
            const char* a1 = cA + (size_t)(t + 1) * kstep;
            const char* a2 = last ? nA : cA + (size_t)(t + 2) * kstep; const char* b2 = last ? nB : cB + (size_t)(t + 2) * kstep;
            const char* a3 = a2 + kstep; const char* b3 = b2 + kstep;
            PG8_LDB(B0, 0, 0); PG8_LDB(B1, 0, 1); PG8_SCHED; PG8_LDA(At, 0, 0); PG8_STAGE(PG8_SA(1, 1), a1 + hstepA, voffA);
            PG8_WAIT_V(8); PG8_WAIT_L(0); PG8_BAR; PG8_MMA(0, 0, At, B0); PG8_MMA(0, 1, At, B1); PG8_BAR; PG8_SCHED;
            PG8_LDA(At, 0, 1); PG8_STAGE(PG8_SB(0, 0), b2, voffB); PG8_STAGE(PG8_SB(0, 1), b2 + hstepB, voffB); PG8_STAGE(PG8_SA(0, 0), a2, voffA);
            PG8_WAIT_V(8); PG8_WAIT_L(0); PG8_BAR; PG8_MMA(1, 0, At, B0); PG8_MMA(1, 1, At, B1); PG8_BAR; PG8_SCHED;
            PG8_LDB(B0, 1, 0); PG8_LDB(B1, 1, 1); PG8_SCHED; PG8_LDA(At, 1, 0); PG8_STAGE(PG8_SA(0, 1), a2 + hstepA, voffA);
            PG8_WAIT_V(8); PG8_WAIT_L(0); PG8_BAR; PG8_MMA(0, 0, At, B0); PG8_MMA(0, 1, At, B1); PG8_BAR; PG8_SCHED;
            PG8_LDA(At, 1, 1); PG8_STAGE(PG8_SB(1, 0), b3, voffB); PG8_STAGE(PG8_SB(1, 1), b3 + hstepB, voffB); PG8_STAGE(PG8_SA(1, 0), a3, voffA);
            PG8_WAIT_V(8); PG8_WAIT_L(0); PG8_BAR; PG8_MMA(1, 0, At, B0); PG8_MMA(1, 1, At, B1); PG8_BAR; PG8_SCHED;
        }
        if (!cur.chain) {
            if constexpr (ALIGN_EPI) { if (wr == 0) PG8_BAR; }
            E(acc, cur, wr, wc, fr, fq);
        }
        if (!has_next) break;
        if (!cur.chain) {
#pragma unroll
            for (int a = 0; a < 2; ++a)
#pragma unroll
                for (int b = 0; b < 2; ++b)
#pragma unroll
                    for (int m = 0; m < 4; ++m)
#pragma unroll
                        for (int n = 0; n < 2; ++n) acc[a][b][m][n] = (f32x4){0.f, 0.f, 0.f, 0.f};
            if constexpr (ALIGN_EPI) { if (wr == 1) PG8_BAR; }
        }
        cur = nxt; cA = nA; cB = nB; ++ui;
    }
    PG8_WAIT_V(0);
    if constexpr (!ALIGN_EPI) { if (wr == 0) PG8_BAR; }
    PG8_BAR;
#undef PG8_SA
#undef PG8_SB
#undef PG8_STAGE
#undef PG8_LDA
#undef PG8_LDB
#undef PG8_MMA
#undef PG8_WAIT_V
#undef PG8_WAIT_L
#undef PG8_BAR
#undef PG8_SCHED
}
}
using pg8::Unit; using pg8::Gemm;

struct Args {
    const float *x, *norm1_g, *w_in, *gla_wg2, *gla_bg, *gla_norm_g, *w_proj_gla, *q_norm_g, *k_norm_g, *idx_k_norm_g, *w_proj_dsa, *b_gate, *w_out, *norm2_g, *w_ff1, *w_ff2;
    float* out; unsigned char* ws; int ph_lo, ph_hi;
};

enum { M_INPROJ = 0, M_INDEX, M_G0, M_G1, M_G2, M_MERGE, M_OUT, M_FF1, M_FF2 };
__device__ __forceinline__ void st8bf(bf16_t* p, f32x4 a, f32x4 b) { *(u32x4*)p = pack8(a, b); }
__device__ __forceinline__ float sigm(float v) { return 1.f / (1.f + __expf(-v)); }

template <int MODE> struct Epi {
    static constexpr bool PERM = true;
    const Args* ap; int batch;
    __device__ __forceinline__ void operator()(const f32x4 (&acc)[2][2][4][2], const Unit& u, int wr, int wc, int fr, int fq) const {
        asm volatile("" : "+v"(fr), "+v"(fq));
        const Args& A = *ap; unsigned char* ws = A.ws;
        if constexpr (MODE == M_INDEX) {
            const float* IW = (const float*)(ws + WS_IW);
            f32x4 w[2][2];
#pragma unroll
            for (int bj = 0; bj < 2; ++bj) { const int t = u.pn * 16 + bj * 8 + wc * 2 + (fq >> 1); const float* wp = IW + (size_t)(batch * SEQ + t) * 16 + (fq & 1) * 8;
                w[bj][0] = *(const f32x4*)wp; w[bj][1] = *(const f32x4*)(wp + 4); }
            _Float16* SC = (_Float16*)(ws + WS_SC);
#pragma unroll
            for (int ai = 0; ai < 2; ++ai)
#pragma unroll
                for (int m = 0; m < 4; ++m) { const int s = u.pm * 256 + ai * 128 + wr * 64 + m * 16 + fr;
#pragma unroll
                    for (int bj = 0; bj < 2; ++bj) { const int t = u.pn * 16 + bj * 8 + wc * 2 + (fq >> 1);
                        const f32x4 v0 = acc[ai][bj][m][0], v1 = acc[ai][bj][m][1]; float sc = 0.f;
#pragma unroll
                        for (int q = 0; q < 4; ++q) { sc += w[bj][0][q] * fmaxf(v0[q], 0.f); sc += w[bj][1][q] * fmaxf(v1[q], 0.f); }
                        sc += shx(sc, 16, fq * 16 + fr);
                        if (!(fq & 1)) SC[(size_t)t * SEQ + s] = (_Float16)sc; } }
        } else {
            f32x4 cb[2][2];
            if constexpr (MODE == M_INPROJ) { if (u.pn >= 44 && u.pn < 60) {
#pragma unroll
                for (int bj = 0; bj < 2; ++bj) { const float* bp = A.b_gate + (u.pn - 44) * 256 + bj * 128 + wc * 32 + fq * 8; cb[bj][0] = *(const f32x4*)bp; cb[bj][1] = *(const f32x4*)(bp + 4); } } }
            if constexpr (MODE == M_G0) {
#pragma unroll
                for (int bj = 0; bj < 2; ++bj) { const float* bl = (const float*)(ws + WS_BLAST) + u.aux * 256 + bj * 128 + wc * 32 + fq * 8; const f32x4 e0 = *(const f32x4*)bl, e1 = *(const f32x4*)(bl + 4);
#pragma unroll
                    for (int q = 0; q < 4; ++q) { cb[bj][0][q] = __expf(e0[q]); cb[bj][1][q] = __expf(e1[q]); } } }
#pragma unroll
            for (int ai = 0; ai < 2; ++ai) {
                u32x4 pg[4][2], pu[4][2]; f32x4 px[4][2][2];
                float rstd[4]; (void)rstd;
                if constexpr (MODE == M_FF1) {
#pragma unroll
                    for (int m = 0; m < 4; ++m) rstd[m] = rsqrtf(((const float*)(ws + WS_RSS))[u.pm * 256 + ai * 128 + wr * 64 + m * 16 + fr] * (1.f / 2048.f) + EPS);
                }
                if constexpr (MODE == M_MERGE || MODE == M_OUT || MODE == M_FF2) {
#pragma unroll
                    for (int m = 0; m < 4; ++m)
#pragma unroll
                        for (int bj = 0; bj < 2; ++bj) { const int r = u.pm * 256 + ai * 128 + wr * 64 + m * 16 + fr, col = u.pn * 256 + bj * 128 + wc * 32 + fq * 8;
                            if constexpr (MODE == M_MERGE) { pg[m][bj] = *(const u32x4*)((const bf16_t*)A.out + (size_t)r * 4096 + u.aux * 2048 + col);
                                if (u.aux) pu[m][bj] = *(const u32x4*)((const bf16_t*)(ws + WS_U) + (size_t)r * 2048 + col); }
                            else { const float* xp = (MODE == M_OUT ? A.x : A.out) + (size_t)r * 2048 + col; px[m][bj][0] = *(const f32x4*)xp; px[m][bj][1] = *(const f32x4*)(xp + 4); } }
                }
#pragma unroll
                for (int m = 0; m < 4; ++m) {
                    const int rl = ai * 128 + wr * 64 + m * 16 + fr; const int r = u.pm * 256 + rl;
                    float rowss = 0.f; (void)rowss;
#pragma unroll
                    for (int bj = 0; bj < 2; ++bj) {
                        const int cl = bj * 128 + wc * 32 + fq * 8;
                        f32x4 v0 = acc[ai][bj][m][0], v1 = acc[ai][bj][m][1];
                        if constexpr (MODE == M_INPROJ) {
                            const int pn = u.pn;
                            if (pn < 4) { st8bf((bf16_t*)(ws + WS_GQ) + (size_t)r * 1024 + pn * 256 + cl, v0 * 0.0625f, v1 * 0.0625f); }
                            else if (pn < 8) { st8bf((bf16_t*)(ws + WS_GK) + (size_t)r * 1024 + (pn - 4) * 256 + cl, v0, v1); }
                            else if (pn < 16) {
                                const int col = (pn - 8) * 256 + cl, h = col >> 9, e = col & 511, b = r >> 13, s = r & 8191, c = s >> 8, j = s & 255;
                                bf16_t* p = (bf16_t*)(ws + WS_VT) + ((size_t)(((b * 4 + h) * 32 + c) * 512 + e)) * 256 + j;
#pragma unroll
                                for (int q = 0; q < 4; ++q) { p[q * 256] = f2bf(v0[q]); p[(q + 4) * 256] = f2bf(v1[q]); }
                            }
                            else if (pn < 24) {
#pragma unroll
                                for (int q = 0; q < 4; ++q) { v0[q] = v0[q] * sigm(v0[q]); v1[q] = v1[q] * sigm(v1[q]); }
                                st8bf((bf16_t*)(ws + WS_GR) + (size_t)r * 2048 + (pn - 16) * 256 + cl, v0, v1); }
                            else if (pn < 32) { st8bf((bf16_t*)(ws + WS_DQ) + (size_t)r * 2048 + (pn - 24) * 256 + cl, v0, v1); }
                            else if (pn < 36) {
                                const int col = ((pn - 32) & 1) * 256 + cl, kvh = col >> 7, d = col & 127, b = r >> 13, s = r & 8191;
                                bf16_t* base = (bf16_t*)(ws + (pn < 34 ? WS_DK : WS_DV));
                                st8bf(base + ((size_t)((b * 4 + kvh) * 8192 + s)) * 128 + d, v0, v1); }
                            else if (pn < 44) { st8bf((bf16_t*)(ws + WS_IQ) + (size_t)r * 2048 + (pn - 36) * 256 + cl, v0, v1); }
                            else if (pn < 60) {
                                const int col = (pn - 44) * 256 + cl;
#pragma unroll
                                for (int q = 0; q < 4; ++q) { v0[q] = sigm(v0[q] + cb[bj][0][q]); v1[q] = sigm(v1[q] + cb[bj][1][q]); }
                                st8bf((bf16_t*)A.out + (size_t)r * 4096 + col, v0, v1); }
                            else {
                                if (cl < 16) { float* p = (float*)(ws + WS_GLR) + (size_t)r * 16 + cl; *(f32x4*)p = v0; *(f32x4*)(p + 4) = v1; }
                                else if (cl < 32) { float* p = (float*)(ws + WS_IW) + (size_t)r * 16 + (cl - 16); *(f32x4*)p = v0 * 0.25f; *(f32x4*)(p + 4) = v1 * 0.25f; }
                                else if (cl < 160) { st8bf((bf16_t*)(ws + WS_IK) + (size_t)r * 128 + (cl - 32), v0, v1); }
                            }
                        } else if constexpr (MODE == M_G0) {
                            v0 = v0 * cb[bj][0]; v1 = v1 * cb[bj][1];
                            st8bf((bf16_t*)(ws + WS_ST) + ((size_t)u.aux * 512 + u.pm * 256 + rl) * 256 + cl, v0, v1);
                        } else if constexpr (MODE == M_G1) {
#pragma unroll
                            for (int q = 0; q < 4; ++q) { if (cl + q > rl) v0[q] = 0.f; if (cl + 4 + q > rl) v1[q] = 0.f; }
                            st8bf((bf16_t*)(ws + WS_P) + ((size_t)u.aux * 256 + rl) * 256 + cl, v0, v1);
                        } else if constexpr (MODE == M_G2) {
                            const int uu = u.aux, c = uu & 31, h = (uu >> 5) & 3, b = uu >> 7;
                            st8bf((bf16_t*)(ws + WS_OG) + ((size_t)(b * 8192 + c * 256 + rl)) * 2048 + h * 512 + u.pn * 256 + cl, v0, v1);
                        } else if constexpr (MODE == M_MERGE) {
                            const int col = u.pn * 256 + cl;
                            const u32x4 gw = pg[m][bj];
                            bf16_t* up = (bf16_t*)(ws + WS_U) + (size_t)r * 2048 + col;
                            f32x4 g0 = {bflo(gw.x), bfhi(gw.x), bflo(gw.y), bfhi(gw.y)}, g1 = {bflo(gw.z), bfhi(gw.z), bflo(gw.w), bfhi(gw.w)};
                            v0 = v0 * g0; v1 = v1 * g1;
                            if (u.aux) { const u32x4 pw = pu[m][bj]; v0 += (f32x4){bflo(pw.x), bfhi(pw.x), bflo(pw.y), bfhi(pw.y)}; v1 += (f32x4){bflo(pw.z), bfhi(pw.z), bflo(pw.w), bfhi(pw.w)}; }
                            st8bf(up, v0, v1);
                        } else if constexpr (MODE == M_OUT) {
                            const size_t o = (size_t)r * 2048 + u.pn * 256 + cl;
                            const f32x4 y0 = px[m][bj][0] + v0, y1 = px[m][bj][1] + v1;
                            *(f32x4*)(A.out + o) = y0; *(f32x4*)(A.out + o + 4) = y1;
                            st8bf((bf16_t*)(ws + WS_H2) + o, y0, y1);
#pragma unroll
                            for (int q = 0; q < 4; ++q) rowss += y0[q] * y0[q] + y1[q] * y1[q];
                        } else if constexpr (MODE == M_FF1) {
#pragma unroll
                            for (int q = 0; q < 4; ++q) { const float a = fmaxf(v0[q], 0.f) * rstd[m], b = fmaxf(v1[q], 0.f) * rstd[m]; v0[q] = a * a; v1[q] = b * b; }
                            st8bf((bf16_t*)(ws + WS_HM) + (size_t)r * 8192 + u.pn * 256 + cl, v0, v1);
                        } else if constexpr (MODE == M_FF2) {
                            float* o = A.out + (size_t)r * 2048 + u.pn * 256 + cl;
                            *(f32x4*)o = px[m][bj][0] + v0; *(f32x4*)(o + 4) = px[m][bj][1] + v1;
                        }
                    }
                    if constexpr (MODE == M_OUT) {
                        const int ln = fq * 16 + fr;
                        rowss += shx(rowss, 16, ln); rowss += shx(rowss, 32, ln);
                        if (fq == 0) __hip_atomic_fetch_add((float*)(ws + WS_RSS) + r, rowss, __ATOMIC_RELAXED, __HIP_MEMORY_SCOPE_AGENT);
                    }
                }
            }
        }
    }
};

struct IndexOrder {
    int G, c;
    __device__ bool next(int i, Unit& u) const {
        const int L = i * G + c; if (L >= 8448) return false;
        int qb = 0; while (16 * (qb + 1) * (qb + 2) / 2 <= L) ++qb;
        const int rem = L - 16 * qb * (qb + 1) / 2; u.pm = rem >> 4; u.pn = qb * 16 + (rem & 15);
        u.offA = (long)u.pm * 256 * 128 * 2; u.offB = (long)u.pn * 256 * 128 * 2; u.chain = 0; u.aux = 0; return true;
    }
};
struct G0Order {
    int G, c;
    __device__ bool next(int i, Unit& u) const {
        const int L = i * G + c; if (L >= 512) return false;
        const int uu = L >> 1, et = L & 1; u.pm = et; u.pn = 0; u.aux = uu;
        u.offA = (long)(WS_VT) + ((long)uu * 512 + et * 256) * 256 * 2; u.offB = (long)(WS_KT) + (long)uu * 256 * 256 * 2; u.chain = 0; return true;
    }
};
struct G1Order {
    int G, c;
    __device__ bool next(int i, Unit& u) const {
        const int L = i * G + c; if (L >= 256) return false;
        const int c_ = L & 31, h = (L >> 5) & 3, b = L >> 7; u.pm = 0; u.pn = 0; u.aux = L;
        const long off = ((long)(b * 8192 + c_ * 256) * 1024 + h * 256) * 2;
        u.offA = (long)WS_QS + (long)L * 256 * 256 * 2; u.offB = (long)WS_GK + off; u.chain = 0; return true;
    }
};
struct G2Order {
    int G, c;
    __device__ bool next(int i, Unit& u) const {
        const int L = (i >> 1) * G + c; if (L >= 512) return false;
        const int uu = L >> 1, nt_ = L & 1, part = i & 1; u.pm = 0; u.pn = nt_; u.aux = uu;
        if (part == 0) { u.offA = (long)WS_QS + (long)uu * 256 * 256 * 2; u.offB = (long)WS_ST + ((long)uu * 512 + nt_ * 256) * 256 * 2; u.chain = 1; }
        else           { u.offA = (long)WS_P  + (long)uu * 256 * 256 * 2; u.offB = (long)WS_VT + ((long)uu * 512 + nt_ * 256) * 256 * 2; u.chain = 0; }
        return true;
    }
};
struct MergeOrder {
    pg8::StaticOrder so;
    __device__ bool next(int i, Unit& u) const {
        if (!so.next(i >> 1, u)) return false;
        const int which = i & 1; u.aux = which;
        u.offA = (long)(which ? WS_DQ : WS_OG) + (long)u.pm * 256 * 2048 * 2; u.offB = (long)(which ? WS_WPD : WS_WPG) + (long)u.pn * 256 * 2048 * 2; return true;
    }
};

__device__ __forceinline__ int in_dst_row(int n) {
    if (n < 6144) return n;
    if (n < 6160) return 15360 + (n - 6144);
    if (n < 8208) return 6144 + (n - 6160);
    if (n < 8720) return 8192 + (n - 8208);
    if (n < 9232) return 8704 + (n - 8720);
    if (n < 11280) return 9216 + (n - 9232);
    if (n < 11408) return 15360 + 32 + (n - 11280);
    if (n < 11424) return 15360 + 16 + (n - 11408);
    return 11264 + (n - 11424);
}
__device__ __forceinline__ void tr_load(const float* W, int N, int item, int lane, float (&tv)[32]) {
    const int nblk = N / 32, kb = item / nblk, nb = item % nblk, k0 = 64 * kb, n0 = 32 * nb;
#pragma unroll
    for (int i = 0; i < 32; ++i) { const int kk = 2 * i + (lane >> 5); tv[i] = W[(size_t)(k0 + kk) * N + n0 + (lane & 31)]; }
}
template <bool MAP> __device__ __forceinline__ void tr_store(bf16_t* WT, int K, int N, LAS float* scr, int item, int lane, const float (&tv)[32], const float* rs) {
    const int nblk = N / 32, kb = item / nblk, nb = item % nblk, k0 = 64 * kb, n0 = 32 * nb;
#pragma unroll
    for (int i = 0; i < 32; ++i) { const int kk = 2 * i + (lane >> 5); scr[kk * 33 + (lane & 31)] = rs ? tv[i] * rs[k0 + kk] : tv[i]; }
    asm volatile("s_waitcnt lgkmcnt(0)" ::: "memory");
    const int c = lane & 7;
#pragma unroll
    for (int j = 0; j < 4; ++j) { const int n = (lane >> 3) + 8 * j; const LAS float* sp = scr + (8 * c) * 33 + n;
        u32x4 o; o.x = cvt_pk_bf16(sp[0 * 33], sp[1 * 33]); o.y = cvt_pk_bf16(sp[2 * 33], sp[3 * 33]); o.z = cvt_pk_bf16(sp[4 * 33], sp[5 * 33]); o.w = cvt_pk_bf16(sp[6 * 33], sp[7 * 33]);
        const int dr = MAP ? in_dst_row(n0 + n) : (n0 + n);
        *(u32x4*)(WT + (size_t)dr * K + k0 + 8 * c) = o; }
    asm volatile("s_waitcnt lgkmcnt(0)" ::: "memory");
}
struct Cv { const float* W; bf16_t* WT; const float* rs; int K, N, item; };
template <int MODE> __device__ __forceinline__ Cv cv_desc(const Args& A, int it) {
    unsigned char* ws = A.ws; Cv d; d.rs = nullptr;
    if (MODE == 0) { d.W = A.w_in; d.WT = (bf16_t*)(ws + WS_WTIN); d.K = DM; d.N = NPROJ; d.item = it; return d; }
    constexpr int I_P = 32 * 64, I_F = 32 * 256;
    int r = it;
    if (r < I_P) { d.W = A.w_proj_gla; d.WT = (bf16_t*)(ws + WS_WPG); d.K = 2048; d.N = 2048; d.item = r; return d; } r -= I_P;
    if (r < I_P) { d.W = A.w_proj_dsa; d.WT = (bf16_t*)(ws + WS_WPD); d.K = 2048; d.N = 2048; d.item = r; return d; } r -= I_P;
    if (r < I_P) { d.W = A.w_out; d.WT = (bf16_t*)(ws + WS_WO); d.K = 2048; d.N = 2048; d.item = r; return d; } r -= I_P;
    if (r < I_F) { d.W = A.w_ff1; d.WT = (bf16_t*)(ws + WS_WF1); d.K = 2048; d.N = 8192; d.item = r; d.rs = A.norm2_g; return d; } r -= I_F;
    d.W = A.w_ff2; d.WT = (bf16_t*)(ws + WS_WF2); d.K = 8192; d.N = 2048; d.item = r; return d;
}
template <int MODE> __device__ __forceinline__ void convert_pass(const Args& A, LAS float* scr, int nit, int gw, int NGW, int lane) {
    float ta[32], tb[32]; Cv d0, d1; int it = gw;
    if (it < nit) { d0 = cv_desc<MODE>(A, it); tr_load(d0.W, d0.N, d0.item, lane, ta); }
    while (it < nit) {
        const int it2 = it + NGW, it3 = it2 + NGW;
        if (it2 < nit) { d1 = cv_desc<MODE>(A, it2); tr_load(d1.W, d1.N, d1.item, lane, tb); }
        tr_store<MODE == 0>(d0.WT, d0.K, d0.N, scr, d0.item, lane, ta, d0.rs);
        if (it3 < nit) { d0 = cv_desc<MODE>(A, it3); tr_load(d0.W, d0.N, d0.item, lane, ta); }
        if (it2 < nit) tr_store<MODE == 0>(d1.WT, d1.K, d1.N, scr, d1.item, lane, tb, d1.rs);
        it = it3;
    }
}

__device__ __forceinline__ void rms_row2_bf16(const float* xrow, const float* g, bf16_t* orow, int lane) {
    constexpr int NR = 4;
    f32x4 v[NR][8]; float s[NR];
#pragma unroll
    for (int r = 0; r < NR; ++r)
#pragma unroll
        for (int j = 0; j < 8; ++j) v[r][j] = *((const f32x4*)(xrow + (size_t)r * 2048) + 64 * j + lane);
    float rstd[NR];
#pragma unroll
    for (int r = 0; r < NR; ++r) { s[r] = 0.f;
#pragma unroll
        for (int j = 0; j < 8; ++j) s[r] += (v[r][j][0] * v[r][j][0] + v[r][j][1] * v[r][j][1]) + (v[r][j][2] * v[r][j][2] + v[r][j][3] * v[r][j][3]);
        rstd[r] = rsqrtf(wave_sum(s[r], lane) * (1.f / 2048.f) + EPS); }
#pragma unroll
    for (int j = 0; j < 8; ++j) { const f32x4 gg = *((const f32x4*)g + 64 * j + lane);
#pragma unroll
        for (int r = 0; r < NR; ++r) { const f32x4 y = v[r][j] * rstd[r] * gg; u32x2 o; o.x = cvt_pk_bf16(y[0], y[1]); o.y = cvt_pk_bf16(y[2], y[3]); *((u32x2*)(orow + (size_t)r * 2048) + 64 * j + lane) = o; } }
}

template <bool NORM, int ROT> __device__ __forceinline__ void rope_chunk(bf16_t* p, const u32x4 w, const f32x4 (&tb)[4], const float* g, float sc, int lane) {
    const int j = lane & 15;
    float x[8] = {bflo(w.x), bfhi(w.x), bflo(w.y), bfhi(w.y), bflo(w.z), bfhi(w.z), bflo(w.w), bfhi(w.w)};
    if (NORM) {
        float ss = 0.f;
#pragma unroll
        for (int q = 0; q < 8; ++q) ss += x[q] * x[q];
        ss = row16_sum(ss);
        const float rstd = rsqrtf(ss * (1.f / 128.f) + EPS);
        const f32x4 g0 = *(const f32x4*)(g + j * 8), g1 = *(const f32x4*)(g + j * 8 + 4);
#pragma unroll
        for (int q = 0; q < 4; ++q) { x[q] *= rstd * g0[q]; x[4 + q] *= rstd * g1[q]; }
    }
    constexpr int HALFL = ROT / 16;
    const bool rot = (ROT == 128) || (j < 8); const bool first = (j & HALFL) == 0;
    float o[8];
#pragma unroll
    for (int q = 0; q < 8; ++q) {
        const float other = (ROT == 128) ? DPPF(x[q], 0x128)   : shx(x[q], HALFL, lane);
        const float cs = tb[q >> 1][(q & 1) * 2], sn = tb[q >> 1][(q & 1) * 2 + 1];
        const float r = first ? (x[q] * cs - other * sn) : (x[q] * cs + other * sn);
        o[q] = (rot ? r : x[q]) * sc;
    }
    u32x4 ow; ow.x = cvt_pk_bf16(o[0], o[1]); ow.y = cvt_pk_bf16(o[2], o[3]); ow.z = cvt_pk_bf16(o[4], o[5]); ow.w = cvt_pk_bf16(o[6], o[7]);
    *(u32x4*)(p + lane * 8) = ow;
}
template <bool NORM, int ROT, bool PERTOK> __device__ __forceinline__ void rope_pass(bf16_t* base, int nchunks, const float* g, const float* tab, float sc, int gw, int NGW, int lane) {
    constexpr int NB = 8, HALFL = ROT / 16; const int j = lane & 15;
    for (int it0 = gw * NB; it0 < nchunks; it0 += NGW * NB) {
        u32x4 w[NB]; f32x4 tb[NB][4];
#pragma unroll
        for (int k = 0; k < NB; ++k) { const int it = it0 + k;
            w[k] = *(const u32x4*)(base + (size_t)it * 512 + lane * 8);
            const int pos = PERTOK ? ((it >> 2) & 8191) : (((it * 4) & 8191) + (lane >> 4));
            const float* tp = tab + (size_t)pos * ROT + (j & (HALFL - 1)) * 16;
#pragma unroll
            for (int q = 0; q < 4; ++q) tb[k][q] = *(const f32x4*)(tp + q * 4); }
#pragma unroll
        for (int k = 0; k < NB; ++k) rope_chunk<NORM, ROT>(base + (size_t)(it0 + k) * 512, w[k], tb[k], g, sc, lane);
    }
}
__device__ __forceinline__ void post_proj(const Args& A, int gw, int NGW, int lane) {
    unsigned char* ws = A.ws;
    const float* R1 = (const float*)(ws + WS_ROPE1); const float* R2 = (const float*)(ws + WS_ROPE2);
    const float qs = 0.08838834764831845f;
    rope_pass<true, 128, true>((bf16_t*)(ws + WS_DQ), T * 4, A.q_norm_g, R1, qs * 1.4426950408889634f  , gw, NGW, lane);
    rope_pass<true, 128, false>((bf16_t*)(ws + WS_DK), T, A.k_norm_g, R1, 1.f, gw, NGW, lane);
    rope_pass<false, 64, true>((bf16_t*)(ws + WS_IQ), T * 4, nullptr, R2, qs, gw, NGW, lane);
    rope_pass<true, 64, false>((bf16_t*)(ws + WS_IK), T / 4, A.idx_k_norm_g, R2, 1.f, gw, NGW, lane);
}

typedef float f32x16 __attribute__((ext_vector_type(16)));
__device__ __forceinline__ void idx_stream(unsigned char* ws, LAS unsigned char* lds, int bb, int bid, int G, int wave, int lane, int tid) {
    const bf16_t* IQ = (const bf16_t*)(ws + WS_IQ) + (size_t)bb * SEQ * 2048;
    const bf16_t* IK = (const bf16_t*)(ws + WS_IK) + (size_t)bb * SEQ * 128;
    const float* IW = (const float*)(ws + WS_IW) + (size_t)bb * SEQ * 16;
    _Float16* SC = (_Float16*)(ws + WS_SC);
    constexpr int NT = 8320, PITCH = 272, TK = 128;
    const int g0 = (int)(((long)bid * NT) / G), g1 = (int)(((long)(bid + 1) * NT) / G);
    if (g0 >= g1) return;
    int u = 0, pu = 0;
    while (pu + ((u + 4) >> 2) <= g0) { pu += (u + 4) >> 2; ++u; }
    const int rho = lane & 31, hi = lane >> 5, ha = rho >> 3, hb = (rho >> 2) & 1, hc = rho & 3;
    const int srow = tid >> 2, sseg = tid & 3;
    bf16x8 af[2][8]; float w[2][16];
    u32x4 st0, st1, st2, st3;
#define IDX_LOADA() do { _Pragma("unroll") for (int rt = 0; rt < 2; ++rt) { const int q = 32 * u + 4 * wave + 2 * rt; \
        const bf16_t* ap = IQ + (size_t)(q + hb) * 2048 + (4 * ha + hc) * 128 + 8 * hi; \
        _Pragma("unroll") for (int ks = 0; ks < 8; ++ks) af[rt][ks] = *(const bf16x8*)(ap + 16 * ks); \
        const f32x4* wp = (const f32x4*)(IW + (size_t)(q + hi) * 16); \
        _Pragma("unroll") for (int k4 = 0; k4 < 4; ++k4) { const f32x4 t4 = wp[k4]; w[rt][4 * k4] = t4[0]; w[rt][4 * k4 + 1] = t4[1]; w[rt][4 * k4 + 2] = t4[2]; w[rt][4 * k4 + 3] = t4[3]; } } } while (0)
#define IDX_LOADK(kt) do { const bf16_t* kp = IK + (size_t)((kt) * TK + srow) * 128 + sseg * 32; st0 = *(const u32x4*)kp; st1 = *(const u32x4*)(kp + 8); st2 = *(const u32x4*)(kp + 16); st3 = *(const u32x4*)(kp + 24); } while (0)
#define IDX_WRITEK(buf) do { LAS unsigned char* d = lds + (buf) * (TK * PITCH) + srow * PITCH + sseg * 64; *(LAS u32x4*)d = st0; *(LAS u32x4*)(d + 16) = st1; *(LAS u32x4*)(d + 32) = st2; *(LAS u32x4*)(d + 48) = st3; } while (0)
    IDX_LOADA();
    IDX_LOADK(g0 - pu); IDX_WRITEK(0);
    __syncthreads();
    for (int g = g0; g < g1; ++g) {
        const int kt = g - pu, buf = (g - g0) & 1;
        int un = u, pun = pu; if (g + 1 - pu >= ((u + 4) >> 2)) { pun = pu + ((u + 4) >> 2); un = u + 1; }
        if (g + 1 < g1) IDX_LOADK(g + 1 - pun);
        const LAS unsigned char* kb = lds + buf * (TK * PITCH) + rho * PITCH + hi * 16;
#pragma unroll
        for (int ct = 0; ct < TK / 32; ++ct) {
            bf16x8 bfr[8];
#pragma unroll
            for (int ks = 0; ks < 8; ++ks) bfr[ks] = *(const LAS bf16x8*)(kb + ct * 32 * PITCH + ks * 32);
            f32x16 c0, c1;
#pragma unroll
            for (int r = 0; r < 16; ++r) { c0[r] = 0.f; c1[r] = 0.f; }
#pragma unroll
            for (int ks = 0; ks < 8; ++ks) { c0 = __builtin_amdgcn_mfma_f32_32x32x16_bf16(af[0][ks], bfr[ks], c0, 0, 0, 0); c1 = __builtin_amdgcn_mfma_f32_32x32x16_bf16(af[1][ks], bfr[ks], c1, 0, 0, 0); }
            float s0 = 0.f, s1 = 0.f;
#pragma unroll
            for (int r = 0; r < 16; ++r) { s0 += w[0][r] * fmaxf(c0[r], 0.f); s1 += w[1][r] * fmaxf(c1[r], 0.f); }
            const int key = kt * TK + ct * 32 + rho, q = 32 * u + 4 * wave + hi;
            SC[(size_t)q * SEQ + key] = (_Float16)s0; SC[(size_t)(q + 2) * SEQ + key] = (_Float16)s1;
        }
        if (g + 1 < g1) IDX_WRITEK(buf ^ 1);
        if (un != u && g + 1 < g1) { u = un; pu = pun; IDX_LOADA(); }
        __syncthreads();
    }
#undef IDX_LOADA
#undef IDX_LOADK
#undef IDX_WRITEK
}

__device__ __forceinline__ void select_one(const unsigned short* sc, int t, unsigned short* idx, int lane, LAS unsigned short* li, LAS unsigned* hist) {
    if (t < 256) {
#pragma unroll
        for (int j = 0; j < 4; ++j) { const int i = j * 64 + lane; idx[i] = (unsigned short)(i <= t ? i : 0); }
        return;
    }
    unsigned key[128];
    const int ngrp = (t >> 9) + 1;
    u32x4 wv[16];
#pragma unroll
    for (int gI = 0; gI < 16; ++gI) wv[gI] = *(const u32x4*)(sc + gI * 512 + lane * 8);
#pragma unroll
    for (int gI = 0; gI < 16; ++gI) {
        const int s0 = gI * 512 + lane * 8; const u32x4 w = wv[gI];
#pragma unroll
        for (int q = 0; q < 8; ++q) { const unsigned wd = w[q >> 1]; const unsigned h = (q & 1) ? (wd >> 16) : (wd & 0xffffu);
            const unsigned k = (h & 0x8000u) ? (~h & 0xffffu) : (h | 0x8000u); key[gI * 8 + q] = (s0 + q <= t) ? k : 0u; }
    }
    unsigned thr = 0u; int ngt = 0;
    {
        const unsigned hbase = (unsigned)(size_t)hist;
        int above = 0; unsigned prefix = 0u;
#pragma unroll
        for (int pass = 0; pass < 2; ++pass) {
            *(LAS u32x4*)(hist + lane * 4) = (u32x4){0u, 0u, 0u, 0u};
            asm volatile("s_waitcnt lgkmcnt(0)" ::: "memory");
#pragma unroll
            for (int gI = 0; gI < 16; ++gI) if (gI < ngrp) {
#pragma unroll
                for (int q = 0; q < 8; ++q) { const unsigned k = key[gI * 8 + q];
                    const bool in = pass == 0 ? (k != 0u) : ((k >> 8) == prefix);
                    const unsigned bin = pass == 0 ? (k >> 8) : (k & 255u);
                    if (in) asm volatile("ds_add_u32 %0, %1" :: "v"(hbase + bin * 4u), "v"(1u) : "memory"); }
            }
            asm volatile("s_waitcnt lgkmcnt(0)" ::: "memory");
            const u32x4 h = *(const LAS u32x4*)(hist + lane * 4);
            const int sl = (int)(h.x + h.y + h.z + h.w), want = 256 - above;
            int run = 0, L = 63;
            for (; L > 0; --L) { const int v = __builtin_amdgcn_readlane(sl, L); if (run + v >= want) break; run += v; }
            int bin = 4 * L;
            { const int h3 = __builtin_amdgcn_readlane((int)h.w, L), h2 = __builtin_amdgcn_readlane((int)h.z, L), h1 = __builtin_amdgcn_readlane((int)h.y, L);
              if (run + h3 >= want) bin += 3; else { run += h3; if (run + h2 >= want) bin += 2; else { run += h2; if (run + h1 >= want) bin += 1; else run += h1; } } }
            above += run;
            if (pass == 0) prefix = (unsigned)bin; else thr = (prefix << 8) | (unsigned)bin;
        }
        ngt = above;
    }
    const int need = 256 - ngt; int bgt = 0, beq = 0;
#pragma unroll
    for (int gI = 0; gI < 16; ++gI) if (gI < ngrp) {
#pragma unroll
        for (int q = 0; q < 8; ++q) {
            const unsigned k = key[gI * 8 + q];
            const unsigned long long ms = __ballot(k >= thr);
            if (ms != 0ull) {
                const int s = gI * 512 + lane * 8 + q;
                const unsigned long long mg = __ballot(k > thr), me = ms & ~mg;
                const int rg = __builtin_amdgcn_mbcnt_hi((unsigned)(mg >> 32), __builtin_amdgcn_mbcnt_lo((unsigned)mg, 0u));
                const int re = __builtin_amdgcn_mbcnt_hi((unsigned)(me >> 32), __builtin_amdgcn_mbcnt_lo((unsigned)me, 0u));
                if (k > thr) li[bgt + rg] = (unsigned short)s;
                else if (k == thr && beq + re < need) li[ngt + beq + re] = (unsigned short)s;
                bgt += __popcll(mg); beq += __popcll(me);
            }
        }
    }
    asm volatile("s_waitcnt lgkmcnt(0)" ::: "memory");
    *(u32x2*)(idx + lane * 4) = *(const LAS u32x2*)(li + lane * 4);
}

__device__ __forceinline__ void attend_one(unsigned char* ws, LAS unsigned char* lds, int wave, int bb, int t, int kvh, int lane) {
    asm volatile("" : "+v"(lane));
    const int n = lane & 15, g = lane >> 4;
    const bf16_t* Kb = (const bf16_t*)(ws + WS_DK) + (size_t)(bb * 4 + kvh) * 8192 * 128;
    const bf16_t* Vb = (const bf16_t*)(ws + WS_DV) + (size_t)(bb * 4 + kvh) * 8192 * 128;
    bf16_t* qrow = (bf16_t*)(ws + WS_DQ) + (size_t)(bb * 8192 + t) * 2048 + kvh * 512;
    const unsigned short* ix = (const unsigned short*)(ws + WS_IDX) + (size_t)(bb * 8192 + t) * 256;
    const int cnt = t < 255 ? t + 1 : 256;
    LAS unsigned* li = (LAS unsigned*)(lds + wave * 1024);
    { const u32x2 iw = *(const u32x2*)(ix + lane * 4); *(LAS u32x4*)(li + lane * 4) = (u32x4){(iw.x & 0xffffu) << 8, (iw.x >> 16) << 8, (iw.y & 0xffffu) << 8, (iw.y >> 16) << 8}; }
    bf16x8 qf[4];
#pragma unroll
    for (int kk = 0; kk < 4; ++kk) { qf[kk] = (bf16x8){0, 0, 0, 0, 0, 0, 0, 0}; if (n < 4) qf[kk] = *(const bf16x8*)(qrow + n * 128 + kk * 32 + g * 8); }
    asm volatile("s_waitcnt vmcnt(0) lgkmcnt(0)" ::: "memory");
    bf16x8 ka[2][4][4];
#define ATT_LOADK(buf, grp) do { _Pragma("unroll") for (int tl = 0; tl < 4; ++tl) { const unsigned ko = li[((grp) * 4 + tl) * 16 + n] + (unsigned)g * 16u; \
        _Pragma("unroll") for (int kk = 0; kk < 4; ++kk) ka[buf][tl][kk] = *(const bf16x8*)((const char*)Kb + (ko + kk * 64u)); } } while (0)
    ATT_LOADK(0, 0); ATT_LOADK(1, 1);
    __builtin_amdgcn_sched_barrier(0);
    f32x4 S[16];
#pragma unroll
    for (int gi = 0; gi < 4; ++gi) {
#pragma unroll
        for (int tl = 0; tl < 4; ++tl) { f32x4 a = {0.f, 0.f, 0.f, 0.f};
#pragma unroll
            for (int kk = 0; kk < 4; ++kk) a = __builtin_amdgcn_mfma_f32_16x16x32_bf16(ka[gi & 1][tl][kk], qf[kk], a, 0, 0, 0);
            S[gi * 4 + tl] = a; }
        __builtin_amdgcn_sched_barrier(0);
        if (gi + 2 < 4) { ATT_LOADK(gi & 1, gi + 2); __builtin_amdgcn_sched_barrier(0); }
    }
#undef ATT_LOADK
    u32x4 R[3][8];
#define ATT_LOADV(buf, ks) do { const u32x4 i0 = *(const LAS u32x4*)(li + (ks) * 32 + 4 * g), i1 = *(const LAS u32x4*)(li + (ks) * 32 + 16 + 4 * g); \
        const unsigned kidx[8] = {i0.x, i0.y, i0.z, i0.w, i1.x, i1.y, i1.z, i1.w}; \
        _Pragma("unroll") for (int jj = 0; jj < 8; ++jj) R[buf][jj] = *(const u32x4*)((const char*)Vb + (kidx[jj] + (unsigned)n * 16u)); } while (0)
    ATT_LOADV(0, 0); ATT_LOADV(1, 1); ATT_LOADV(2, 2);
    __builtin_amdgcn_sched_barrier(0);
    if (cnt < 256) {
#pragma unroll
        for (int kt = 0; kt < 16; ++kt)
#pragma unroll
            for (int j = 0; j < 4; ++j) if (4 * g + j >= cnt - kt * 16) S[kt][j] = -3.0e38f;
    }
    f32x4 mx4 = S[0];
#pragma unroll
    for (int kt = 1; kt < 16; ++kt) mx4 = __builtin_elementwise_max(mx4, S[kt]);
    float mx = fmaxf(fmaxf(mx4[0], mx4[1]), fmaxf(mx4[2], mx4[3]));
    mx = fmaxf(mx, shx(mx, 16, lane)); mx = fmaxf(mx, shx(mx, 32, lane));
    f32x4 sum4 = {0.f, 0.f, 0.f, 0.f};
#pragma unroll
    for (int kt = 0; kt < 16; ++kt) { f32x4 d = S[kt] - mx;
#pragma unroll
        for (int j = 0; j < 4; ++j) d[j] = __builtin_amdgcn_exp2f(d[j]);
        S[kt] = d; sum4 += d; }
    float sum = (sum4[0] + sum4[1]) + (sum4[2] + sum4[3]);
    sum += shx(sum, 16, lane); sum += shx(sum, 32, lane);
    const float inv = 1.f / sum;
    u32x4 pa[8];
#pragma unroll
    for (int ks = 0; ks < 8; ++ks) pa[ks] = pack8(S[2 * ks], S[2 * ks + 1]);
    f32x4 O[8];
#pragma unroll
    for (int dt = 0; dt < 8; ++dt) O[dt] = (f32x4){0.f, 0.f, 0.f, 0.f};
    __builtin_amdgcn_sched_barrier(0);
#pragma unroll
    for (int ks = 0; ks < 8; ++ks) {
        const bf16x8 pk = __builtin_bit_cast(bf16x8, pa[ks]);
#pragma unroll
        for (int w = 0; w < 4; ++w) {
            u32x4 lo, hi;
#pragma unroll
            for (int a = 0; a < 4; ++a) { lo[a] = __builtin_amdgcn_perm(R[ks % 3][2 * a + 1][w], R[ks % 3][2 * a][w], 0x05040100u); hi[a] = __builtin_amdgcn_perm(R[ks % 3][2 * a + 1][w], R[ks % 3][2 * a][w], 0x07060302u); }
            O[2 * w] = __builtin_amdgcn_mfma_f32_16x16x32_bf16(pk, __builtin_bit_cast(bf16x8, lo), O[2 * w], 0, 0, 0);
            O[2 * w + 1] = __builtin_amdgcn_mfma_f32_16x16x32_bf16(pk, __builtin_bit_cast(bf16x8, hi), O[2 * w + 1], 0, 0, 0);
        }
        __builtin_amdgcn_sched_barrier(0);
        if (ks + 3 < 8) { ATT_LOADV(ks % 3, ks + 3); __builtin_amdgcn_sched_barrier(0); }
    }
#undef ATT_LOADV
#pragma unroll
    for (int j = 0; j < 4; ++j) {
        const float iv = __int_as_float(__builtin_amdgcn_readlane(__float_as_int(inv), j));
        if (g == 0) { f32x4 a = {O[0][j] * iv, O[1][j] * iv, O[2][j] * iv, O[3][j] * iv}, b = {O[4][j] * iv, O[5][j] * iv, O[6][j] * iv, O[7][j] * iv};
            st8bf(qrow + j * 128 + n * 8, a, b); }
    }
}

__device__ __forceinline__ float log_a_of(const LAS float* glr, const float (&w)[16], float bgc) {
    float z = bgc;
    const f32x4 g0 = *(const LAS f32x4*)glr, g1 = *(const LAS f32x4*)(glr + 4), g2 = *(const LAS f32x4*)(glr + 8), g3 = *(const LAS f32x4*)(glr + 12);
#pragma unroll
    for (int k = 0; k < 4; ++k) z += g0[k] * w[k] + g1[k] * w[4 + k] + g2[k] * w[8 + k] + g3[k] * w[12 + k];
    return -(fmaxf(-z, 0.f) + __logf(1.f + __expf(-fabsf(z)))) * 0.0625f;
}
__device__ __forceinline__ void gla_prep(const Args& A, LAS float* sm, int uu, int tid) {
    unsigned char* ws = A.ws;
    const int ch = tid & 255, half = __builtin_amdgcn_readfirstlane(tid >> 8);
    const int c = uu & 31, h = (uu >> 5) & 3, b = uu >> 7;
    const int tok0 = b * 8192 + c * 256 + half * 128;
    float w[16];
#pragma unroll
    for (int k = 0; k < 16; ++k) w[k] = A.gla_wg2[k * 1024 + h * 256 + ch];
    const float bgc = A.gla_bg[h * 256 + ch];
    {
        const f32x4* src = (const f32x4*)((const float*)(ws + WS_GLR) + (size_t)(b * 8192 + c * 256) * 16);
        LAS f32x4* dst = (LAS f32x4*)(sm + 1024);
        dst[tid] = src[tid]; dst[tid + 512] = src[tid + 512];
    }
    __syncthreads();
    const LAS float* GLR = sm + 1024 + half * 128 * 16;
    float s = 0.f;
#pragma unroll 4
    for (int tt = 0; tt < 128; ++tt) s += log_a_of(GLR + tt * 16, w, bgc);
    sm[half * 256 + ch] = s;
    __syncthreads();
    const float tot0 = sm[ch], blast = sm[ch] + sm[256 + ch];
    __syncthreads();
    if (half == 0) ((float*)(ws + WS_BLAST))[uu * 256 + ch] = blast;
    float bcur = half ? tot0 : 0.f;
    const bf16_t* GQ = (const bf16_t*)(ws + WS_GQ); bf16_t* GK = (bf16_t*)(ws + WS_GK);
    bf16_t* QS = (bf16_t*)(ws + WS_QS) + (size_t)uu * 256 * 256; bf16_t* KT = (bf16_t*)(ws + WS_KT) + ((size_t)uu * 256 + ch) * 256 + half * 128;
    unsigned short qn[8], kn[8];
#pragma unroll
    for (int q = 0; q < 8; ++q) { const size_t o = (size_t)(tok0 + q) * 1024 + h * 256 + ch; qn[q] = GQ[o]; kn[q] = GK[o]; }
    for (int t8 = 0; t8 < 16; ++t8) {
        float kp[8], qv[8], kv[8];
#pragma unroll
        for (int q = 0; q < 8; ++q) { qv[q] = bf2f(qn[q]); kv[q] = bf2f(kn[q]); }
        if (t8 < 15) {
#pragma unroll
            for (int q = 0; q < 8; ++q) { const size_t o = (size_t)(tok0 + (t8 + 1) * 8 + q) * 1024 + h * 256 + ch; qn[q] = GQ[o]; kn[q] = GK[o]; }
        }
#pragma unroll
        for (int q = 0; q < 8; ++q) {
            const int tt = t8 * 8 + q; const size_t tok = (size_t)(tok0 + tt);
            bcur += log_a_of(GLR + tt * 16, w, bgc);
            const float eb = __expf(bcur), ieb = __expf(-bcur);
            QS[(size_t)(half * 128 + tt) * 256 + ch] = f2bf(qv[q] * eb);
            kp[q] = kv[q] * ieb;
            GK[tok * 1024 + h * 256 + ch] = f2bf(kp[q]);
        }
        u32x4 o; o.x = cvt_pk_bf16(kp[0], kp[1]); o.y = cvt_pk_bf16(kp[2], kp[3]); o.z = cvt_pk_bf16(kp[4], kp[5]); o.w = cvt_pk_bf16(kp[6], kp[7]);
        *(u32x4*)(KT + t8 * 8) = o;
    }
}
__device__ __forceinline__ void gla_scan(unsigned char* ws, int gt, int NGT) {
    const float* BL = (const float*)(ws + WS_BLAST);
    for (int it = gt; it < 8 * 512 * 32; it += NGT) {
        const int d8 = it & 31, e = (it >> 5) & 511, bh = it >> 14;
        float S[8];
#pragma unroll
        for (int q = 0; q < 8; ++q) S[q] = 0.f;
        for (int c0 = 0; c0 < 32; c0 += 4) {
            u32x4 uw[4]; f32x4 d0[4], d1[4];
#pragma unroll
            for (int k = 0; k < 4; ++k) { const int uu = bh * 32 + c0 + k;
                uw[k] = *(const u32x4*)((const bf16_t*)(ws + WS_ST) + ((size_t)uu * 512 + e) * 256 + d8 * 8);
                d0[k] = *(const f32x4*)(BL + uu * 256 + d8 * 8); d1[k] = *(const f32x4*)(BL + uu * 256 + d8 * 8 + 4); }
#pragma unroll
            for (int k = 0; k < 4; ++k) { const int uu = bh * 32 + c0 + k;
                u32x4 o; o.x = cvt_pk_bf16(S[0], S[1]); o.y = cvt_pk_bf16(S[2], S[3]); o.z = cvt_pk_bf16(S[4], S[5]); o.w = cvt_pk_bf16(S[6], S[7]);
                *(u32x4*)((bf16_t*)(ws + WS_ST) + ((size_t)uu * 512 + e) * 256 + d8 * 8) = o;
                S[0] = S[0] * __expf(d0[k][0]) + bflo(uw[k].x); S[1] = S[1] * __expf(d0[k][1]) + bfhi(uw[k].x); S[2] = S[2] * __expf(d0[k][2]) + bflo(uw[k].y); S[3] = S[3] * __expf(d0[k][3]) + bfhi(uw[k].y);
                S[4] = S[4] * __expf(d1[k][0]) + bflo(uw[k].z); S[5] = S[5] * __expf(d1[k][1]) + bfhi(uw[k].z); S[6] = S[6] * __expf(d1[k][2]) + bflo(uw[k].w); S[7] = S[7] * __expf(d1[k][3]) + bfhi(uw[k].w); }
        }
    }
}
__device__ __forceinline__ void gla_post(const Args& A, int gw, int NGW, int lane) {
    unsigned char* ws = A.ws;
    const f32x4 g0 = *(const f32x4*)(A.gla_norm_g + lane * 8), g1 = *(const f32x4*)(A.gla_norm_g + lane * 8 + 4);
    for (int it0 = gw * 4; it0 < T * 4; it0 += NGW * 4) {
        u32x4 xw[4], gw4[4];
#pragma unroll
        for (int k = 0; k < 4; ++k) { const int it = it0 + k; const size_t o = (size_t)(it >> 2) * 2048 + (it & 3) * 512 + lane * 8;
            xw[k] = *(const u32x4*)((const bf16_t*)(ws + WS_OG) + o); gw4[k] = *(const u32x4*)((const bf16_t*)(ws + WS_GR) + o); }
#pragma unroll
        for (int k = 0; k < 4; ++k) { const int it = it0 + k; const size_t o = (size_t)(it >> 2) * 2048 + (it & 3) * 512 + lane * 8;
            f32x4 x0 = {bflo(xw[k].x), bfhi(xw[k].x), bflo(xw[k].y), bfhi(xw[k].y)}, x1 = {bflo(xw[k].z), bfhi(xw[k].z), bflo(xw[k].w), bfhi(xw[k].w)};
            const f32x4 r0 = {bflo(gw4[k].x), bfhi(gw4[k].x), bflo(gw4[k].y), bfhi(gw4[k].y)}, r1 = {bflo(gw4[k].z), bfhi(gw4[k].z), bflo(gw4[k].w), bfhi(gw4[k].w)};
            float ss = 0.f;
#pragma unroll
            for (int q = 0; q < 4; ++q) ss += x0[q] * x0[q] + x1[q] * x1[q];
            const float rstd = rsqrtf(wave_sum(ss, lane) * (1.f / 512.f) + EPS);
            x0 = x0 * rstd * g0 * r0; x1 = x1 * rstd * g1 * r1;
            *(u32x4*)((bf16_t*)(ws + WS_OG) + o) = pack8(x0, x1); }
    }
}

#define XB_TMO      128
#define XB_XCNT(j)  (256  + 64 * (j))
#define XB_XSUB(j)  (1280 + 64 * (j))
#define XB_XGEN(j)  (2304 + 64 * (j))
#define XB_TOP      3328
#define XB_TOPGEN   3392
#define XCD_BAR_WORDS 3456
#define XB_SPIN_CAP (1u << 22)
#define RLX_AGENT __ATOMIC_RELAXED, __HIP_MEMORY_SCOPE_AGENT
__device__ __forceinline__ unsigned xb_ld(unsigned* p)              { return __hip_atomic_load(p, RLX_AGENT); }
__device__ __forceinline__ unsigned xb_add(unsigned* p, unsigned v) { return __hip_atomic_fetch_add(p, v, RLX_AGENT); }
__device__ __forceinline__ unsigned xb_xcc_id() { return (unsigned)__builtin_amdgcn_s_getreg((3 << 11) | 20) & 0xFu; }
#define XB_SPIN(cond, bar) do { unsigned _sp = 0; while (cond) { __builtin_amdgcn_s_sleep(1); \
    if ((++_sp & 255u) == 0u) { if (xb_ld(&(bar)[XB_TMO])) break; if (_sp > XB_SPIN_CAP) { atomicAdd(&(bar)[XB_TMO], 1u); break; } } } } while (0)
__device__ __forceinline__ void xcd_barrier_complete(unsigned* bar, unsigned x, unsigned G, unsigned& nloc, unsigned& nx) {
    unsigned sum, cnt, mine, sp = 0u;
    for (;;) {
        sum = 0u; cnt = 0u; mine = 0u;
#pragma unroll
        for (unsigned j = 0; j < 16; ++j) { const unsigned c = xb_ld(&bar[XB_XCNT(j)]); sum += c; cnt += (c > 0u) ? 1u : 0u; mine = (j == x) ? c : mine; }
        if (sum == G) break;
        __builtin_amdgcn_s_sleep(1);
        if ((++sp & 255u) == 0u) { if (xb_ld(&bar[XB_TMO])) break; if (sp > XB_SPIN_CAP) { atomicAdd(&bar[XB_TMO], 1u); break; } }
    }
    nloc = mine > 0u ? mine : 1u; nx = cnt > 0u ? cnt : 1u;
}
__device__ __forceinline__ void grid_bar(unsigned* bar, volatile LAS unsigned* st, unsigned G, int wave) {
    asm volatile("s_waitcnt vmcnt(0) lgkmcnt(0)" ::: "memory");
    __syncthreads();
    int l; asm volatile("v_mbcnt_lo_u32_b32 %0, -1, 0\n\tv_mbcnt_hi_u32_b32 %0, -1, %0" : "=v"(l));
    if (wave == 0 && l == 0) {
        const unsigned x = xb_xcc_id();
        __builtin_amdgcn_s_waitcnt(0);
        unsigned nloc = st[0], nx = st[1];
        if (nloc == 0u) { xcd_barrier_complete(bar, x, G, nloc, nx); st[0] = nloc; st[1] = nx; }
        const unsigned old = xb_add(&bar[XB_XSUB(x)], 1u);
        const unsigned gen = old / nloc;
        if (old + 1u == (gen + 1u) * nloc) {
            __builtin_amdgcn_fence(__ATOMIC_RELEASE, "agent");
            asm volatile("s_waitcnt vmcnt(0)" ::: "memory");
            const unsigned og = xb_add(&bar[XB_TOP], 1u);
            const unsigned tg = og / nx;
            if (og + 1u == (tg + 1u) * nx) xb_add(&bar[XB_TOPGEN], 1u);
            else XB_SPIN(xb_ld(&bar[XB_TOPGEN]) == tg, bar);
            __builtin_amdgcn_fence(__ATOMIC_ACQUIRE, "agent");
            xb_add(&bar[XB_XGEN(x)], 1u);
            asm volatile("s_waitcnt vmcnt(0)" ::: "memory");
        } else {
            XB_SPIN(xb_ld(&bar[XB_XGEN(x)]) == gen, bar);
            __builtin_amdgcn_fence(__ATOMIC_ACQUIRE, "agent");
            asm volatile("s_waitcnt vmcnt(0)" ::: "memory");
        }
    }
    __syncthreads();
}
__device__ __forceinline__ Args load_args() {
    Args a{};
#if defined(__HIP_DEVICE_COMPILE__)
    const __attribute__((address_space(4))) unsigned long long* q = (const __attribute__((address_space(4))) unsigned long long*)__builtin_amdgcn_kernarg_segment_ptr();
    asm volatile("" : "+s"(q));
    unsigned long long* d = (unsigned long long*)&a;
#pragma unroll
    for (int i = 0; i < (int)(sizeof(Args) / 8); ++i) d[i] = q[i];
#endif
    return a;
}
__global__ void __launch_bounds__(512, 2) hybrid_fwd(Args A0) {
    extern __shared__ __attribute__((aligned(16))) unsigned char lds_raw[];
    LAS unsigned char* lds = (LAS unsigned char*)lds_raw;
    cg::grid_group grid = cg::this_grid();
    unsigned char* ws = A0.ws; const int ph_lo = A0.ph_lo, ph_hi = A0.ph_hi;
    const int G = gridDim.x, bid = blockIdx.x;
    const int NGW = G * 8;
    const int wave = __builtin_amdgcn_readfirstlane(threadIdx.x >> 6);
    const Gemm gws{(const bf16_t*)ws, (const bf16_t*)ws, 256, 256, 256};
    int ph = 0;
    volatile LAS unsigned* bst = (volatile LAS unsigned*)(lds + 131072);
    { int l0; asm volatile("v_mbcnt_lo_u32_b32 %0, -1, 0\n\tv_mbcnt_hi_u32_b32 %0, -1, %0" : "=v"(l0));
      if (wave == 0 && l0 == 0) { const unsigned x0 = xb_xcc_id(); bst[0] = 0u; bst[1] = 0u; bst[3] = x0; bst[2] = xb_add(&((unsigned*)ws)[XB_XCNT(x0)], 1u); } }
    grid.sync();
#ifndef PHMASK
#define PHMASK 0xffffffffu
#endif
#define PHASE_BEGIN(id) if (((PHMASK >> (id)) & 1u) && ph >= ph_lo && ph < ph_hi) { const Args A = load_args(); int lane; asm volatile("v_mbcnt_lo_u32_b32 %0, -1, 0\n\tv_mbcnt_hi_u32_b32 %0, -1, %0" : "=v"(lane)); const int tid = wave * 64 + lane, gw = bid * 8 + wave; (void)tid; LAS float* scr = (LAS float*)(lds + wave * 16384); (void)lane; (void)gw; (void)scr;
#define PHASE_END_NOBAR } ++ph; __syncthreads();
#define PHASE_END } ++ph; if (ph > ph_lo && ph < ph_hi) { grid_bar((unsigned*)ws, bst, (unsigned)G, wave); }

    PHASE_BEGIN(0)
        convert_pass<0>(A, scr, 32 * (NPROJ / 32), gw, NGW, lane);
        for (int m = gw * 4; m < T; m += NGW * 4) rms_row2_bf16(A.x + (size_t)m * DM, A.norm1_g, (bf16_t*)(ws + WS_H) + (size_t)m * DM, lane);
        for (int i = bid * 512 + tid; i < T; i += G * 512) ((float*)(ws + WS_RSS))[i] = 0.f;
        for (int i = bid * 512 + tid; i < SEQ * 96; i += G * 512) {
            const int pos = i / 96, j = i % 96;
            if (j < 64) { const float f = powf(10000.f, -(float)j * 2.0f / 128.f); const float a = (float)pos * f; float sn, cs; sincosf(a, &sn, &cs);
                ((float*)(ws + WS_ROPE1))[(size_t)pos * 128 + j * 2] = cs; ((float*)(ws + WS_ROPE1))[(size_t)pos * 128 + j * 2 + 1] = sn; }
            else { const int jj = j - 64; const float f = powf(10000.f, -(float)jj * 2.0f / 64.f); const float a = (float)pos * f; float sn, cs; sincosf(a, &sn, &cs);
                ((float*)(ws + WS_ROPE2))[(size_t)pos * 64 + jj * 2] = cs; ((float*)(ws + WS_ROPE2))[(size_t)pos * 64 + jj * 2 + 1] = sn; }
        }
    PHASE_END
    PHASE_BEGIN(1)
        const Gemm g{(const bf16_t*)(ws + WS_H), (const bf16_t*)(ws + WS_WTIN), DM, DM, DM};
        pg8::StaticOrder S; S.init(T, NPROJ_PAD, DM, DM, G, bid);
        Epi<M_INPROJ> E{&A, 0};
        pg8::gemm_phase<Epi<M_INPROJ>, pg8::StaticOrder, true>(lds, g, S, E, wave);
    PHASE_END
    PHASE_BEGIN(2)
        post_proj(A, gw, NGW, lane);
    PHASE_END
#define DSA_ROUND(bb, ATT_END) \
        PHASE_BEGIN(3) \
            idx_stream(ws, lds, bb, bid, G, wave, lane, tid); \
        PHASE_END \
        PHASE_BEGIN(4) \
            for (int t = gw; t < SEQ; t += NGW) \
                select_one((const unsigned short*)(ws + WS_SC) + (size_t)t * SEQ, t, (unsigned short*)(ws + WS_IDX) + (size_t)(bb * SEQ + t) * 256, lane, (LAS unsigned short*)(lds + wave * 512), (LAS unsigned*)(lds + 4096 + wave * 1024)); \
        PHASE_END \
        PHASE_BEGIN(5) \
            const bool xl = (G == 256) && bst[0] == 32u && bst[1] == 8u && bst[3] < 8u; const int xq = (int)bst[3], kvh0 = xq & 3, qh = (xq >> 2) & 1, lw = (int)bst[2] * 8 + wave; \
            for (int it = gw, k = 0; xl ? (k < 16) : (it < SEQ * 4); it += NGW, ++k) attend_one(ws, lds, wave, bb, xl ? (lw + 256 * k) * 2 + qh : (it >> 2), xl ? kvh0 : (it & 3), lane); \
        ATT_END
    DSA_ROUND(0, PHASE_END_NOBAR)
    DSA_ROUND(1, PHASE_END)
#undef DSA_ROUND
    PHASE_BEGIN(6)
        for (int uu = bid; uu < 256; uu += G) { gla_prep(A, (LAS float*)lds, uu, tid); __syncthreads(); }
    PHASE_END
    PHASE_BEGIN(7)
        { G0Order S{G, bid}; Epi<M_G0> E{&A, 0}; pg8::gemm_phase<Epi<M_G0>, G0Order, true>(lds, gws, S, E, wave); }
        { Gemm g1 = gws; g1.lda = 256; g1.ldb = 1024; G1Order S{G, bid}; Epi<M_G1> E{&A, 0}; pg8::gemm_phase<Epi<M_G1>, G1Order, true>(lds, g1, S, E, wave); }
    PHASE_END
    PHASE_BEGIN(8)
        gla_scan(ws, bid * 512 + tid, G * 512);
    PHASE_END
    PHASE_BEGIN(9)
        G2Order S{G, bid}; Epi<M_G2> E{&A, 0}; pg8::gemm_phase<Epi<M_G2>, G2Order, true>(lds, gws, S, E, wave);
    PHASE_END
    PHASE_BEGIN(10)
        gla_post(A, gw, NGW, lane);
        convert_pass<1>(A, scr, 3 * (32 * 64) + 2 * (32 * 256), gw, NGW, lane);
    PHASE_END
    PHASE_BEGIN(11)
        Gemm g = gws; g.lda = 2048; g.ldb = 2048; g.K = 2048;
        MergeOrder S; S.so.init(T, DM, DM, DM, G, bid, 4); Epi<M_MERGE> E{&A, 0};
        pg8::gemm_phase<Epi<M_MERGE>, MergeOrder, true>(lds, g, S, E, wave);
    PHASE_END
    PHASE_BEGIN(12)
        const Gemm g{(const bf16_t*)(ws + WS_U), (const bf16_t*)(ws + WS_WO), DM, DM, DM};
        pg8::StaticOrder S; S.init(T, DM, DM, DM, G, bid, 4); Epi<M_OUT> E{&A, 0};
        pg8::gemm_phase<Epi<M_OUT>, pg8::StaticOrder, true>(lds, g, S, E, wave);
    PHASE_END
    PHASE_BEGIN(14)
        const Gemm g{(const bf16_t*)(ws + WS_H2), (const bf16_t*)(ws + WS_WF1), DM, DM, DM};
        pg8::StaticOrder S; S.init(T, DFF, DM, DM, G, bid); Epi<M_FF1> E{&A, 0};
        pg8::gemm_phase<Epi<M_FF1>, pg8::StaticOrder, true>(lds, g, S, E, wave);
    PHASE_END
    PHASE_BEGIN(15)
        const Gemm g{(const bf16_t*)(ws + WS_HM), (const bf16_t*)(ws + WS_WF2), DFF, DFF, DFF};
        pg8::StaticOrder S; S.init(T, DM, DFF, DFF, G, bid, 4); Epi<M_FF2> E{&A, 0};
        pg8::gemm_phase<Epi<M_FF2>, pg8::StaticOrder, true>(lds, g, S, E, wave);
    PHASE_END
}

constexpr int LDS_BYTES = 131072 + 4096;
extern "C" void kernel_launch(void* const* d_in, const int* in_sizes, int n_in, void* d_out, int out_size, void* d_ws, size_t ws_size, hipStream_t stream) {
    static int grid = 0;
    if (grid == 0) {
        if (n_in != 16 || ws_size < WS_NEED) { fprintf(stderr, "kernel_launch: need 16 inputs and >= %zu bytes of workspace (got %d, %zu)\n", (size_t)WS_NEED, n_in, ws_size); grid = -1; return; }
        int dev = 0, cus = 0, per_cu = 0;
        hipGetDevice(&dev); hipDeviceGetAttribute(&cus, hipDeviceAttributeMultiprocessorCount, dev);
        if (hipFuncSetAttribute((const void*)hybrid_fwd, hipFuncAttributeMaxDynamicSharedMemorySize, LDS_BYTES) != hipSuccess) { fprintf(stderr, "kernel_launch: hipFuncSetAttribute failed\n"); grid = -1; return; }
        if (hipOccupancyMaxActiveBlocksPerMultiprocessor(&per_cu, (const void*)hybrid_fwd, 512, LDS_BYTES) != hipSuccess || per_cu < 1) { fprintf(stderr, "kernel_launch: occupancy query gave %d\n", per_cu); per_cu = 1; }
        (void)hipGetLastError();
        grid = cus * 1;
    }
    if (grid < 0) return;
    Args a{};
    const float** f = (const float**)&a;
    for (int i = 0; i < 16; ++i) f[i] = (const float*)d_in[i];
    a.out = (float*)d_out; a.ws = (unsigned char*)d_ws; a.ph_lo = 0; a.ph_hi = 1000;
    if (hipMemsetAsync(d_ws, 0, 16384, stream) != hipSuccess) { fprintf(stderr, "kernel_launch: memset failed\n"); return; }
    void* args[] = {&a};
    hipError_t e = hipLaunchCooperativeKernel((const void*)hybrid_fwd, dim3(grid), dim3(512), args, LDS_BYTES, stream);
    if (e != hipSuccess) fprintf(stderr, "cooperative launch failed: %s (grid %d)\n", hipGetErrorString(e), grid);
}
```
